# Optimizing an MI355X kernel written in HIP

```python
import jax, jax.numpy as jnp
from jax import lax
import numpy as np

D_MODEL = 2048
BATCH = 4
SEQ = 2048
DEPTH = 2
DEC_BATCH = 128
DEC_SEQ = 4
PAST_LEN = 16384
PAGE_SIZE = 128

D_CONV = D_MODEL // 2
CONV_A_WIDTH = 3
N_HEADS = 8
HEAD_DIM = 128
D_GDN = N_HEADS * HEAD_DIM
GDN_CONV_WIDTH = 4
CHUNK = 64
D_FF = 4 * D_MODEL
ALPHA = (2 * DEPTH) ** 0.25
BETA_INIT = (8 * DEPTH) ** -0.25
LN_EPS = 1e-5
NORM_EPS = 1e-6
SPLITS = (D_CONV, D_CONV, D_CONV, D_GDN, D_GDN, D_GDN, D_GDN, N_HEADS, N_HEADS, D_MODEL, D_MODEL)
D_PROJ = sum(SPLITS)

kernel_name = 'hybrid_shortconv_gdn_deepnorm_step'


def layer_norm(x, g, b):
    xf = x.astype(jnp.float32)
    mu = jnp.mean(xf, -1, keepdims=True)
    var = jnp.mean(jnp.square(xf - mu), -1, keepdims=True)
    return ((xf - mu) * lax.rsqrt(var + LN_EPS) * g.astype(jnp.float32) + b.astype(jnp.float32)).astype(x.dtype)


def l2norm(x):
    xf = x.astype(jnp.float32)
    return xf * lax.rsqrt(jnp.sum(xf * xf, -1, keepdims=True) + NORM_EPS)


def causal_depthwise_conv(u, buf, w):
    K = w.shape[0]
    L = u.shape[1]
    full = jnp.concatenate([buf.astype(u.dtype), u], axis=1)
    out = sum(full[:, j:j + L] * w[j] for j in range(K))
    return out, full[:, -(K - 1):]


def gated_delta_rule(q, k, v, g, beta, S0):
    Bsz, L, H, DK = q.shape
    DV = v.shape[-1]
    C = min(CHUNK, L)
    Lp = -(-L // C) * C
    pad = Lp - L
    if pad:
        padf = lambda a: jnp.pad(a, [(0, 0), (0, pad)] + [(0, 0)] * (a.ndim - 2))
        q, k, v, g, beta = padf(q), padf(k), padf(v), padf(g), padf(beta)
    N = Lp // C

    def chunks(a):
        return a.reshape(Bsz, N, C, H, -1).transpose(1, 0, 3, 2, 4)

    qc = chunks(q * (DK ** -0.5))
    kc = chunks(k)
    vc = chunks(v)
    gc = chunks(g[..., None])[..., 0]
    bc = chunks(beta[..., None])
    gcum = jnp.cumsum(gc, axis=-1)
    idx = jnp.arange(C)
    causal = idx[:, None] >= idx[None, :]
    strict = idx[:, None] > idx[None, :]
    diff = gcum[..., :, None] - gcum[..., None, :]
    decay = jnp.where(causal, jnp.exp(jnp.where(causal, diff, 0.0)), 0.0)
    kb = kc * bc
    M = jnp.where(strict, jnp.einsum('nbhid,nbhjd->nbhij', kb, kc) * decay, 0.0)
    eye = jnp.eye(C, dtype=jnp.float32)
    T = lax.linalg.triangular_solve(eye + M, jnp.broadcast_to(eye, M.shape),
                                    left_side=True, lower=True, unit_diagonal=True)
    u = T @ (vc * bc)
    w = T @ (kb * jnp.exp(gcum)[..., None])
    attn = jnp.einsum('nbhid,nbhjd->nbhij', qc, kc) * decay
    glast = gcum[..., -1:]
    kdec = kc * jnp.exp(glast - gcum)[..., None]
    qdec = qc * jnp.exp(gcum)[..., None]

    def step(S, xs):
        qd, kd, u_c, w_c, a_c, gl = xs
        v_new = u_c - w_c @ S
        o = qd @ S + a_c @ v_new
        S = S * jnp.exp(gl)[..., None] + jnp.einsum('bhcd,bhce->bhde', kd, v_new)
        return S, o

    S, o = lax.scan(step, S0, (qdec, kdec, u, w, attn, glast))
    o = o.transpose(1, 0, 3, 2, 4).reshape(Bsz, Lp, H, DV)[:, :L]
    return o, S


def hybrid_layer(x, conv_a_buf, gdn_buf, S0, w_in, conv_a_w, gdn_conv_w, a_log, dt_bias, gdn_norm_w,
                 w_a_out, w_b_out, w_o, ln1_g, ln1_b, w_up, w_down, ln2_g, ln2_b):
    Bsz, L, _ = x.shape
    proj = x @ w_in
    split_points = np.cumsum(SPLITS)[:-1].tolist()
    gB, gC, h, q, k, v, z, b_logit, a_logit, m_a, m_b = jnp.split(proj, split_points, axis=-1)

    conv_out, new_conv_a = causal_depthwise_conv(gC * h, conv_a_buf, conv_a_w)
    y_a = (gB * conv_out) @ w_a_out

    qkv, new_gdn_buf = causal_depthwise_conv(jnp.concatenate([q, k, v], -1), gdn_buf, gdn_conv_w)
    q, k, v = jnp.split(jax.nn.silu(qkv), 3, axis=-1)
    hs = (Bsz, L, N_HEADS, HEAD_DIM)
    qh = l2norm(q.reshape(hs))
    kh = l2norm(k.reshape(hs))
    vh = v.reshape(hs).astype(jnp.float32)
    beta = jax.nn.sigmoid(b_logit.astype(jnp.float32))
    g = -jnp.exp(a_log.astype(jnp.float32)) * jax.nn.softplus(a_logit.astype(jnp.float32) + dt_bias.astype(jnp.float32))
    o, S = gated_delta_rule(qh, kh, vh, g, beta, S0.astype(jnp.float32))
    o = o * lax.rsqrt(jnp.mean(o * o, -1, keepdims=True) + NORM_EPS) * gdn_norm_w.astype(jnp.float32)
    o = o * jax.nn.silu(z.reshape(hs).astype(jnp.float32))
    y_b = o.reshape(Bsz, L, D_GDN).astype(x.dtype) @ w_b_out

    merged = jax.nn.sigmoid(m_a) * y_a + jax.nn.sigmoid(m_b) * y_b
    x = layer_norm(ALPHA * x + merged @ w_o, ln1_g, ln1_b)
    hid = jnp.square(jax.nn.relu(x @ w_up))
    x = layer_norm(ALPHA * x + hid @ w_down, ln2_g, ln2_b)
    return x, new_conv_a, new_gdn_buf, S.astype(S0.dtype)


def run_trunk(x, st_conv_a, st_gdn_conv, st_gdn, w_in, conv_a_w, gdn_conv_w, a_log, dt_bias, gdn_norm_w,
              w_a_out, w_b_out, w_o, ln1_g, ln1_b, w_up, w_down, ln2_g, ln2_b):
    ca, cg, sg = [], [], []
    for l in range(DEPTH):
        x, c1, c2, s = hybrid_layer(x, st_conv_a[l], st_gdn_conv[l], st_gdn[l], w_in[l], conv_a_w[l], gdn_conv_w[l],
                                    a_log[l], dt_bias[l], gdn_norm_w[l], w_a_out[l], w_b_out[l], w_o[l],
                                    ln1_g[l], ln1_b[l], w_up[l], w_down[l], ln2_g[l], ln2_b[l])
        ca.append(c1)
        cg.append(c2)
        sg.append(s)
    return x, jnp.stack(ca), jnp.stack(cg), jnp.stack(sg)


def setup_inputs(seed: int = 0) -> dict:
    key = jax.random.key(seed)
    ks = jax.random.split(key, 24)
    f32 = jnp.float32
    nrm = lambda k, shape, s: jax.random.normal(k, shape, f32) * s
    col_scale = jnp.concatenate([
        jnp.ones((2 * D_CONV,), f32), jnp.full((D_CONV,), BETA_INIT, f32),
        jnp.ones((2 * D_GDN,), f32), jnp.full((D_GDN,), BETA_INIT, f32),
        jnp.ones((D_GDN + 2 * N_HEADS + 2 * D_MODEL,), f32)])
    dt = jnp.exp(jax.random.uniform(ks[5], (DEPTH, N_HEADS), f32, np.log(1e-3), np.log(1e-1)))
    return {
        'x_prompt': nrm(ks[0], (BATCH, SEQ, D_MODEL), 1.0),
        'x_sample': nrm(ks[1], (DEC_BATCH, DEC_SEQ, D_MODEL), 1.0),
        'state_conv_a': nrm(ks[2], (DEPTH, DEC_BATCH, CONV_A_WIDTH - 1, D_CONV), 1.0),
        'state_gdn_conv': nrm(ks[3], (DEPTH, DEC_BATCH, GDN_CONV_WIDTH - 1, 3 * D_GDN), 1.0),
        'state_gdn': nrm(ks[4], (DEPTH, DEC_BATCH, N_HEADS, HEAD_DIM, HEAD_DIM), 0.1),
        'w_in': nrm(ks[6], (DEPTH, D_MODEL, D_PROJ), D_MODEL ** -0.5) * col_scale,
        'conv_a_w': nrm(ks[7], (DEPTH, CONV_A_WIDTH, D_CONV), CONV_A_WIDTH ** -0.5),
        'gdn_conv_w': nrm(ks[8], (DEPTH, GDN_CONV_WIDTH, 3 * D_GDN), GDN_CONV_WIDTH ** -0.5),
        'a_log': jnp.log(jax.random.uniform(ks[9], (DEPTH, N_HEADS), f32, 1.0, 16.0)),
        'dt_bias': dt + jnp.log(-jnp.expm1(-dt)),
        'gdn_norm_w': 1.0 + nrm(ks[10], (DEPTH, HEAD_DIM), 0.02),
        'w_a_out': nrm(ks[11], (DEPTH, D_CONV, D_MODEL), BETA_INIT * D_CONV ** -0.5),
        'w_b_out': nrm(ks[12], (DEPTH, D_GDN, D_MODEL), BETA_INIT * D_GDN ** -0.5),
        'w_o': nrm(ks[13], (DEPTH, D_MODEL, D_MODEL), BETA_INIT * D_MODEL ** -0.5),
        'ln1_g': 1.0 + nrm(ks[14], (DEPTH, D_MODEL), 0.02),
        'ln1_b': nrm(ks[15], (DEPTH, D_MODEL), 0.02),
        'w_up': nrm(ks[16], (DEPTH, D_MODEL, D_FF), BETA_INIT * D_MODEL ** -0.5),
        'w_down': nrm(ks[17], (DEPTH, D_FF, D_MODEL), BETA_INIT * D_FF ** -0.5),
        'ln2_g': 1.0 + nrm(ks[18], (DEPTH, D_MODEL), 0.02),
        'ln2_b': nrm(ks[19], (DEPTH, D_MODEL), 0.02),
    }


def reference(x_prompt, x_sample, state_conv_a, state_gdn_conv, state_gdn, w_in, conv_a_w, gdn_conv_w, a_log,
              dt_bias, gdn_norm_w, w_a_out, w_b_out, w_o, ln1_g, ln1_b, w_up, w_down, ln2_g, ln2_b):
    bp = x_prompt.shape[0]
    dtp = x_prompt.dtype
    z_conv_a = jnp.zeros((DEPTH, bp, CONV_A_WIDTH - 1, D_CONV), dtp)
    z_gdn_conv = jnp.zeros((DEPTH, bp, GDN_CONV_WIDTH - 1, 3 * D_GDN), dtp)
    z_gdn = jnp.zeros((DEPTH, bp, N_HEADS, HEAD_DIM, HEAD_DIM), dtp)
    y_prompt, new_conv_a_prompt, new_gdn_conv_prompt, new_gdn_prompt = run_trunk(
        x_prompt, z_conv_a, z_gdn_conv, z_gdn, w_in, conv_a_w, gdn_conv_w, a_log, dt_bias, gdn_norm_w,
        w_a_out, w_b_out, w_o, ln1_g, ln1_b, w_up, w_down, ln2_g, ln2_b)
    y_sample, new_conv_a_sample, new_gdn_conv_sample, new_gdn_sample = run_trunk(
        x_sample, state_conv_a, state_gdn_conv, state_gdn, w_in, conv_a_w, gdn_conv_w, a_log, dt_bias, gdn_norm_w,
        w_a_out, w_b_out, w_o, ln1_g, ln1_b, w_up, w_down, ln2_g, ln2_b)
    return (y_prompt, y_sample, new_conv_a_prompt, new_gdn_conv_prompt, new_gdn_prompt,
            new_conv_a_sample, new_gdn_conv_sample, new_gdn_sample)
```

```cpp
#include <hip/hip_runtime.h>
#include <cstdio>
#include <cstdint>

#define LAS __attribute__((address_space(3)))
#define GAS __attribute__((address_space(1)))
typedef unsigned short bf16_t;
typedef short bf16x8 __attribute__((ext_vector_type(8)));
typedef float f32x4 __attribute__((ext_vector_type(4)));
typedef float f32x2 __attribute__((ext_vector_type(2)));
typedef unsigned u32x4 __attribute__((ext_vector_type(4)));
typedef unsigned u32x2 __attribute__((ext_vector_type(2)));
typedef __bf16 bf16x2_t __attribute__((ext_vector_type(2)));
typedef unsigned char uchar;
typedef int i32x8 __attribute__((ext_vector_type(8)));
typedef int i32x4 __attribute__((ext_vector_type(4)));

constexpr int DM = 2048, NPB = 4, SEQ = 2048, NSB = 128, SSEQ = 4, DEPTH = 2;
constexpr int MP = NPB * SEQ, MSR = NSB * SSEQ, MT = MP + MSR;
constexpr int DCONV = 1024, DGDN = 1024, NH = 8, HD = 128, DFF = 8192;
constexpr int NPROJ_REF = 11280, NPROJ = 11264;
constexpr int CB = 0, CC = 1024, CHH = 2048, CQ = 3072, CK = 4096, CV = 5120, CZ = 6144, CMA = 7168, CMB = 9216;
constexpr float ALPHA = 1.41421356237309515f;
constexpr float LN_EPS = 1e-5f, NORM_EPS = 1e-6f;
#ifndef FP8_SP2
#define FP8_SP2 false
#endif
constexpr int KPART = 8;
constexpr int NCHUNK = SEQ / 64;
constexpr int NPU = NPB * NCHUNK * NH;

constexpr size_t O_YP = 0, O_YS = 16777216, O_CAP = 17825792, O_GCP = 17842176, O_GP = 17915904, O_CAS = 18964480, O_GCS = 19488768, O_GS = 21848064, O_END = 55402496;

constexpr size_t MiB = 1u << 20;
constexpr size_t WS_CTL = 0, CTL_ZERO_BYTES = 1 * MiB;
constexpr size_t WS_WIN = 1 * MiB, WS_WA = 45 * MiB, WS_WB = 49 * MiB, WS_WO = 53 * MiB, WS_WUP = 61 * MiB, WS_WD = 93 * MiB;
constexpr size_t WS_WLG = 125 * MiB, WS_LG = 126 * MiB, WS_GL = 127 * MiB;
constexpr size_t WS_P = 128 * MiB;
constexpr size_t WS_XB = 315 * MiB;
constexpr size_t WS_X = 349 * MiB;
constexpr size_t WS_AIN = 417 * MiB, WS_OB = 434 * MiB, WS_MG = 451 * MiB;
constexpr size_t WS_GDN = 485 * MiB;
constexpr int IMG_W = 17408, IMG_KDT = 18432, IMG_QD = 17408, IMG_ATT = 9216, IMG_UT = 18432, IMG_VNT = 18432, IMG_H = 34816;
constexpr size_t WS_GW = WS_GDN, WS_GKDT = WS_GW + (size_t)NPU * IMG_W, WS_GQD = WS_GKDT + (size_t)NPU * IMG_KDT, WS_GATT = WS_GQD + (size_t)NPU * IMG_QD,
                 WS_GUT = WS_GATT + (size_t)NPU * IMG_ATT, WS_GVNT = WS_GUT + (size_t)NPU * IMG_UT, WS_GH = WS_GVNT + (size_t)NPU * IMG_VNT, WS_GDN_END = WS_GH + (size_t)NPU * IMG_H;
constexpr size_t WS_SLAB = WS_GDN;
constexpr size_t WS_T1 = 616 * MiB;
constexpr size_t WS_XB8 = 650 * MiB;
constexpr size_t WS_WIN8 = 667 * MiB;
constexpr size_t WS_END = 689 * MiB;
static_assert(WS_GDN_END <= WS_T1, "ws map");

__device__ __forceinline__ int lane_now() { int l; asm volatile("v_mbcnt_lo_u32_b32 %0, -1, 0\n\tv_mbcnt_hi_u32_b32 %0, -1, %0" : "=v"(l)); return l; }
#define TID_NOW(wave_s) (((wave_s) << 6) | lane_now())
#if defined(__HIP_DEVICE_COMPILE__)
#define ASSUME_GLOBAL(p) __builtin_assume(!__builtin_amdgcn_is_shared((const void*)(p)) && !__builtin_amdgcn_is_private((const void*)(p)))
#else
#define ASSUME_GLOBAL(p) ((void)0)
#endif
__device__ __forceinline__ unsigned pk2(float lo, float hi) { f32x2 v = {lo, hi}; bf16x2_t b = __builtin_convertvector(v, bf16x2_t); return __builtin_bit_cast(unsigned, b); }
__device__ __forceinline__ i32x8 cat8(bf16x8 lo, bf16x8 hi) { const i32x4 a = __builtin_bit_cast(i32x4, lo), b = __builtin_bit_cast(i32x4, hi); return (i32x8){a[0], a[1], a[2], a[3], b[0], b[1], b[2], b[3]}; }
__device__ __forceinline__ unsigned pk4_fp8(float a, float b, float c, float d) { unsigned w = __builtin_amdgcn_cvt_pk_fp8_f32(a, b, 0u, false); return __builtin_amdgcn_cvt_pk_fp8_f32(c, d, w, true); }
__device__ __forceinline__ unsigned pk4_i8(float a, float b, float c, float d) {
    unsigned w = __builtin_amdgcn_cvt_pk_u8_f32(__builtin_rintf(a) + 128.f, 0, 0u); w = __builtin_amdgcn_cvt_pk_u8_f32(__builtin_rintf(b) + 128.f, 1, w);
    w = __builtin_amdgcn_cvt_pk_u8_f32(__builtin_rintf(c) + 128.f, 2, w); w = __builtin_amdgcn_cvt_pk_u8_f32(__builtin_rintf(d) + 128.f, 3, w); return w ^ 0x80808080u; }
__device__ __forceinline__ float bflo(unsigned w) { return __uint_as_float(w << 16); }
__device__ __forceinline__ float bfhi(unsigned w) { return __uint_as_float(w & 0xffff0000u); }
__device__ __forceinline__ float bf1(bf16_t b) { return __uint_as_float((unsigned)b << 16); }
__device__ __forceinline__ float alpha_() { float a = ALPHA; asm volatile("" : "+s"(a)); return a; }
__device__ __forceinline__ float softplusf_(float x) { return x > 15.f ? x : __logf(1.f + __expf(x)); }
__device__ __forceinline__ float sigmoidf_(float x) { return __builtin_amdgcn_rcpf(1.f + __expf(-x)); }
__device__ __forceinline__ float siluf_(float x) { return x * __builtin_amdgcn_rcpf(1.f + __expf(-x)); }
__device__ __forceinline__ float row_sum16(float v) {
    v += __builtin_bit_cast(float, __builtin_amdgcn_update_dpp(0, __builtin_bit_cast(int, v), 0xB1, 0xF, 0xF, true));
    v += __builtin_bit_cast(float, __builtin_amdgcn_update_dpp(0, __builtin_bit_cast(int, v), 0x4E, 0xF, 0xF, true));
    v += __builtin_bit_cast(float, __builtin_amdgcn_update_dpp(0, __builtin_bit_cast(int, v), 0x141, 0xF, 0xF, true));
    v += __builtin_bit_cast(float, __builtin_amdgcn_update_dpp(0, __builtin_bit_cast(int, v), 0x140, 0xF, 0xF, true));
    return v;
}
__device__ __forceinline__ float wave_sum(float v) {
    v = row_sum16(v);
    const int iv = __builtin_bit_cast(int, v);
    const float a = __builtin_bit_cast(float, __builtin_amdgcn_readlane(iv, 0)), b = __builtin_bit_cast(float, __builtin_amdgcn_readlane(iv, 16)),
                c = __builtin_bit_cast(float, __builtin_amdgcn_readlane(iv, 32)), d = __builtin_bit_cast(float, __builtin_amdgcn_readlane(iv, 48));
    return (a + b) + (c + d);
}
__device__ __forceinline__ void fmac1(float& d, float a, float b) { asm("v_fmac_f32_e32 %0, %1, %2" : "+v"(d) : "v"(a), "v"(b)); }
__device__ __forceinline__ void st_wt16(GAS void* p, u32x4 v) { asm volatile("global_store_dwordx4 %0, %1, off sc1\n\ts_nop 1" :: "v"(p), "v"(v) : "memory"); }
__device__ __forceinline__ void st_wt16f(GAS void* p, f32x4 v) { asm volatile("global_store_dwordx4 %0, %1, off sc1\n\ts_nop 1" :: "v"(p), "v"(v) : "memory"); }
__device__ __forceinline__ void st_wt8(GAS void* p, u32x2 v) { asm volatile("global_store_dwordx2 %0, %1, off sc1\n\ts_nop 0" :: "v"(p), "v"(v) : "memory"); }
#define LDS_WAIT() asm volatile("s_waitcnt lgkmcnt(0)" ::: "memory")
#define LBAR() do { asm volatile("s_waitcnt lgkmcnt(0)" ::: "memory"); __builtin_amdgcn_s_barrier(); asm volatile("" ::: "memory"); } while (0)
#define VM_WAIT() asm volatile("s_waitcnt vmcnt(0)" ::: "memory")

namespace pg8 {
constexpr int BM = 256, BK = 64, HALF = 128, HTB = HALF * BK * 2, STAGE_BYTES = 8 * HTB, NXCD = 8, WGM = 8;
__host__ __device__ __forceinline__ int lds_byte(int r, int c) { const int st = (r >> 4) * 2 + (c >> 5), rr = r & 15, cc = c & 31, ob = rr * 64 + cc * 2; return st * 1024 + (ob ^ (((ob >> 9) & 1) << 5)); }
__host__ __device__ __forceinline__ void stage_rc(int b, int& R, int& C) { const int st = b / 1024, sb = b % 1024, swz = sb ^ (((sb >> 9) & 1) << 5); R = (st >> 1) * 16 + swz / 64; C = (st & 1) * 32 + (swz % 64) / 2; }
__host__ __device__ __forceinline__ int perm32(int rho) { const int n = rho >> 4, i = rho & 15; return 8 * (i >> 2) + 4 * n + (i & 3); }

struct Unit { int pm, pn, k0, nt, part; };
struct Gemm { const GAS bf16_t* A; const GAS bf16_t* Bt; int M, N, K; };

struct StaticOrder {
    int nM, nN, nwg, G, c;
    int ntK;
    __device__ __forceinline__ void init(int M, int N, int K, int G_, int c_) { nM = M / BM; nN = N / BM; nwg = nM * nN; G = G_; c = c_; ntK = K / BK; }
    __device__ __forceinline__ bool next(int i, Unit& u) const {
        const long L = (long)i * G + c; if (L >= nwg || c < 0) return false;
        u.k0 = 0; u.nt = ntK; u.part = -1;
        int wgid = (int)L; { const int q = nwg / NXCD, r = nwg % NXCD, xcd = wgid % NXCD, off = wgid / NXCD; wgid = (xcd < r ? xcd * (q + 1) : r * (q + 1) + (xcd - r) * q) + off; }
        const int nig = WGM * nN, gid = wgid / nig, fm = gid * WGM, gsz = (nM - fm) < WGM ? (nM - fm) : WGM;
        u.pm = fm + ((wgid % nig) % gsz); u.pn = (wgid % nig) / gsz; return true;
    }
    __device__ __forceinline__ void a_ready(const Unit&) const {}
    __device__ __forceinline__ void done(const Unit&) const {}
};

struct SplitOrder {
    int G, c, KP, ntK;
    __device__ __forceinline__ void init(int K, int KP_, int G_, int c_) { G = G_; c = c_; KP = KP_; ntK = K / BK; }
    __device__ __forceinline__ bool next(int i, Unit& u) const {
        const int L = i * G + c; const bool whole = L < 256; const int L2 = L - 256;
        const int x = L & 7, j = L >> 3, tile = L2 / KP, part = L2 - tile * KP, ntp = ntK / KP;
        u.pm = whole ? 4 * x + (j >> 3) : 32 + (tile >> 3); u.pn = whole ? (j & 7) : (tile & 7);
        u.k0 = whole ? 0 : part * ntp; u.nt = whole ? ntK : ntp; u.part = whole ? -1 : part;
        return L2 < 16 * KP;
    }
    __device__ __forceinline__ void a_ready(const Unit&) const {}
    __device__ __forceinline__ void done(const Unit&) const {}
};

struct MixOrder {
    int G, v, cls, ntK, first, count;
    __device__ __forceinline__ void init(int cls_, int K, int G_, int vcu, int c) { G = G_; cls = cls_; ntK = K / BK; v = vcu;
        if (G == 256) {
            if (cls == 1) { if (v < 88) { first = 2 * v; count = 2; } else { first = 176 + (v - 88); count = 1; } }
            else { if (v < 48) { first = 4 * v; count = 4; } else if (v < 88) { first = 192 + 3 * (v - 48); count = 3; } else { first = 312 + 5 * (v - 88); count = 5; } }
        } else { const int n = cls == 1 ? 344 : 1152; first = c; count = (n - c + G - 1) / G; if (count < 0) count = 0; }
    }
    __device__ __forceinline__ bool next(int i, Unit& u) const {
        const int idx = (G == 256) ? first + i : first + i * G;
        int pm, pn;
        if (cls == 1) { const bool nrm = idx < 224; const int j = nrm ? idx : idx - 224; const int n = j >> 3, sp = j / 20, t = j - sp * 20;
            pm = nrm ? n + n / 7 : (sp < 4 ? 8 * sp + 7 : 28 + sp); pn = nrm ? 16 + (j & 7) : 4 + t; }
        else { const bool nrm = idx < 1008; const int j = nrm ? idx : idx - 1008; const int n = j / 36, t = j - n * 36, sp = j / 24, t2 = j - sp * 24;
            pm = nrm ? n + n / 7 : (sp < 4 ? 8 * sp + 7 : 28 + sp); pn = nrm ? (t < 16 ? t : t + 8) : (t2 < 4 ? t2 : t2 + 20); }
        u.pm = pm; u.pn = pn; u.k0 = 0; u.nt = ntK; u.part = -1;
        return i < count;
    }
    __device__ __forceinline__ void a_ready(const Unit&) const {}
    __device__ __forceinline__ void done(const Unit&) const {}
};

template <bool IACC> struct EpiStoreBf16 {
    static constexpr bool PERM = true;
    GAS bf16_t* O; int ldc; float ascale;
    __device__ __forceinline__ void operator()(const f32x4 (&acc)[2][2][4][2], const Unit& u, int wr, int wc, int fr, int fq) const {
        const int row0 = u.pm * BM + wr * 64 + fr, col0 = u.pn * BM + wc * 32 + 8 * fq;
#pragma unroll
        for (int ai = 0; ai < 2; ++ai)
#pragma unroll
            for (int m = 0; m < 4; ++m) { GAS bf16_t* rowp = O + (size_t)(row0 + ai * HALF + m * 16) * ldc + col0;
#pragma unroll
                for (int bj = 0; bj < 2; ++bj) { f32x4 v0, v1;
                    if constexpr (IACC) { const i32x4 i0 = __builtin_bit_cast(i32x4, acc[ai][bj][m][0]), i1 = __builtin_bit_cast(i32x4, acc[ai][bj][m][1]);
#pragma unroll
                        for (int e = 0; e < 4; ++e) { v0[e] = (float)i0[e] * ascale; v1[e] = (float)i1[e] * ascale; } }
                    else { v0 = acc[ai][bj][m][0]; v1 = acc[ai][bj][m][1]; }
                    u32x4 w; w.x = pk2(v0[0], v0[1]); w.y = pk2(v0[2], v0[3]); w.z = pk2(v1[0], v1[1]); w.w = pk2(v1[2], v1[3]);
                    *(GAS u32x4*)(rowp + bj * HALF) = w; } }
    }
};
constexpr float HID_SCALE = 20.f, WD_SCALE = 4096.f;
constexpr float XQ_SCALE = 16.f, WUP_SCALE = 2048.f, WIN_SCALE = 1024.f;
constexpr float AIN_SCALE = 24.f, OB_SCALE = 16.f, WAB_SCALE = 1024.f, MG_SCALE = 64.f, WO_SCALE = 2048.f;
struct EpiRelu2 {
    static constexpr bool PERM = true;
    GAS uchar* O; int ldc; float ascale;
    __device__ __forceinline__ void operator()(const f32x4 (&acc)[2][2][4][2], const Unit& u, int wr, int wc, int fr, int fq) const {
        const int row0 = u.pm * BM + wr * 64 + fr, col0 = u.pn * BM + wc * 32 + 8 * fq;
#pragma unroll
        for (int ai = 0; ai < 2; ++ai)
#pragma unroll
            for (int m = 0; m < 4; ++m) { GAS uchar* rowp = O + (size_t)(row0 + ai * HALF + m * 16) * ldc + col0;
#pragma unroll
                for (int bj = 0; bj < 2; ++bj) { const i32x4 i0 = __builtin_bit_cast(i32x4, acc[ai][bj][m][0]), i1 = __builtin_bit_cast(i32x4, acc[ai][bj][m][1]); f32x4 v0, v1;
#pragma unroll
                    for (int e = 0; e < 4; ++e) { const float a = fmaxf((float)i0[e] * ascale, 0.f), b = fmaxf((float)i1[e] * ascale, 0.f); v0[e] = a * a * HID_SCALE; v1[e] = b * b * HID_SCALE; }
                    *(GAS u32x2*)(rowp + bj * HALF) = (u32x2){pk4_i8(v0[0], v0[1], v0[2], v0[3]), pk4_i8(v1[0], v1[1], v1[2], v1[3])}; } }
    }
};
template <bool ADD, bool IACC> struct EpiGate {
    static constexpr bool PERM = true;
    const GAS bf16_t* P; int ldp, gcol; const GAS bf16_t* T1in; GAS bf16_t* O; int ldc; float ascale;
    __device__ __forceinline__ void operator()(const f32x4 (&acc)[2][2][4][2], const Unit& u, int wr, int wc, int fr, int fq) const {
        const int row0 = u.pm * BM + wr * 64 + fr, col0 = u.pn * BM + wc * 32 + 8 * fq;
#pragma unroll
        for (int ai = 0; ai < 2; ++ai)
#pragma unroll
            for (int m = 0; m < 4; ++m) { const size_t row = (size_t)(row0 + ai * HALF + m * 16);
#pragma unroll
                for (int bj = 0; bj < 2; ++bj) {
                    const u32x4 gv = *(const GAS u32x4*)(P + row * ldp + gcol + col0 + bj * HALF);
                    f32x4 v0, v1;
                    if constexpr (IACC) { const i32x4 i0 = __builtin_bit_cast(i32x4, acc[ai][bj][m][0]), i1 = __builtin_bit_cast(i32x4, acc[ai][bj][m][1]);
#pragma unroll
                        for (int e = 0; e < 4; ++e) { v0[e] = (float)i0[e] * ascale; v1[e] = (float)i1[e] * ascale; } }
                    else { v0 = acc[ai][bj][m][0]; v1 = acc[ai][bj][m][1]; }
                    v0[0] *= sigmoidf_(bflo(gv.x)); v0[1] *= sigmoidf_(bfhi(gv.x)); v0[2] *= sigmoidf_(bflo(gv.y)); v0[3] *= sigmoidf_(bfhi(gv.y));
                    v1[0] *= sigmoidf_(bflo(gv.z)); v1[1] *= sigmoidf_(bfhi(gv.z)); v1[2] *= sigmoidf_(bflo(gv.w)); v1[3] *= sigmoidf_(bfhi(gv.w));
                    if constexpr (ADD) { const u32x4 tv = *(const GAS u32x4*)(T1in + row * ldc + col0 + bj * HALF);
                        v0[0] += bflo(tv.x); v0[1] += bfhi(tv.x); v0[2] += bflo(tv.y); v0[3] += bfhi(tv.y);
                        v1[0] += bflo(tv.z); v1[1] += bfhi(tv.z); v1[2] += bflo(tv.w); v1[3] += bfhi(tv.w);
                        v0 = v0 * MG_SCALE; v1 = v1 * MG_SCALE;
                        *(GAS u32x2*)((GAS uchar*)O + row * ldc + col0 + bj * HALF) = (u32x2){pk4_i8(v0[0], v0[1], v0[2], v0[3]), pk4_i8(v1[0], v1[1], v1[2], v1[3])};
                    } else {
                    u32x4 w; w.x = pk2(v0[0], v0[1]); w.y = pk2(v0[2], v0[3]); w.z = pk2(v1[0], v1[1]); w.w = pk2(v1[2], v1[3]);
                    *(GAS u32x4*)(O + row * ldc + col0 + bj * HALF) = w; } }
                asm volatile("" ::: "memory"); }
    }
};
template <bool IACC> struct EpiResSplit {
    static constexpr bool PERM = false;
    __device__ __forceinline__ static f32x4 cvt(const f32x4& a) { if constexpr (IACC) { const i32x4 i = __builtin_bit_cast(i32x4, a); return (f32x4){(float)i[0], (float)i[1], (float)i[2], (float)i[3]}; } else return a; }
    const GAS float* res; GAS float* out; int ldc; GAS float* slab; int split, nrows_hi; float scale;
    __device__ __forceinline__ void operator()(const f32x4 (&acc)[2][2][4][2], const Unit& u, int wr, int wc, int fr, int fq) const {
        const int row0 = u.pm * BM + wr * 64 + fr, col0 = u.pn * BM + wc * 32 + 4 * fq;
        if (u.part < 0) {
#pragma unroll
            for (int ai = 0; ai < 2; ++ai)
#pragma unroll
                for (int m = 0; m < 4; ++m) { const int r = row0 + ai * HALF + m * 16; const GAS float* rp = res + (size_t)r * ldc + col0; GAS float* op = out + (size_t)r * ldc + col0;
#pragma unroll
                    for (int bj = 0; bj < 2; ++bj)
#pragma unroll
                        for (int n = 0; n < 2; ++n) { const f32x4 bs = *(const GAS f32x4*)(rp + bj * HALF + n * 16); *(GAS f32x4*)(op + bj * HALF + n * 16) = bs * alpha_() + cvt(acc[ai][bj][m][n]) * scale; }
                    if (m & 1) asm volatile("" ::: "memory"); }
        } else {
            GAS float* sb = slab + (size_t)u.part * nrows_hi * ldc;
#pragma unroll
            for (int ai = 0; ai < 2; ++ai)
#pragma unroll
                for (int m = 0; m < 4; ++m) { const int r = row0 + ai * HALF + m * 16 - split; GAS float* op = sb + (size_t)r * ldc + col0;
#pragma unroll
                    for (int bj = 0; bj < 2; ++bj)
#pragma unroll
                        for (int n = 0; n < 2; ++n) *(GAS f32x4*)(op + bj * HALF + n * 16) = cvt(acc[ai][bj][m][n]) * scale; }
        }
    }
};

template <class Epi, class Sched, bool ALIGN_EPI, bool SP2, int MODE = 0>
__device__ __forceinline__ void gemm_phase(LAS uchar* lds, const Gemm g, const Sched& S, const Epi& E, const int wave_s) {
    int tid_ = TID_NOW(wave_s);
    const int tid = tid_, wid = __builtin_amdgcn_readfirstlane(tid >> 6), lane = tid & 63, wr = wid >> 2, wc = wid & 3, fr = lane & 15, fq = lane >> 4;
    constexpr bool FP8 = (MODE == 1);
    const int K = g.K;
    unsigned voffA[2], voffB_[2];
#pragma unroll
    for (int i = 0; i < 2; ++i) { int R, C; stage_rc(tid * 16 + i * 8192, R, C); const int Rb = Epi::PERM ? ((R & ~31) + perm32(R & 31)) : R;
        voffA[i] = (unsigned)(R * K + C) * 2u; voffB_[i] = (unsigned)(Rb * K + C) * 2u; }
    unsigned (&voffB)[2] = Epi::PERM ? voffB_ : voffA;
    const size_t kstep = (size_t)(BK * 2);
    const size_t hstep = (size_t)HALF * K * 2;
    const size_t tstep = 2 * hstep;
    const unsigned ldsw = (unsigned)wid * 1024u;
    const int aoff = lds_byte(wr * 64 + fr, fq * 8), boff = lds_byte(wc * 32 + fr, fq * 8);
#define PG8_SA(b, h) (((b) * 2 + (h)) * HTB)
#define PG8_SB(b, h) ((4 + (b) * 2 + (h)) * HTB)
#define PG8_STAGE(bufoff, gbase, voff) do { _Pragma("unroll") for (int _i = 0; _i < 2; ++_i) \
        __builtin_amdgcn_global_load_lds((const unsigned*)((const char*)(gbase) + (voff)[_i]), (LAS unsigned*)(lds + (bufoff) + ldsw + _i * 8192), 16, 0, 0); } while (0)
#define PG8_LDA(dst, b, h) do { _Pragma("unroll") for (int m = 0; m < 4; ++m) { if constexpr (FP8) dst##8[m] = cat8(*(const LAS bf16x8*)(lds + PG8_SA(b, h) + aoff + m * 2048), *(const LAS bf16x8*)(lds + PG8_SA(b, h) + aoff + m * 2048 + 1024)); \
        else { _Pragma("unroll") for (int k = 0; k < 2; ++k) dst[m][k] = *(const LAS bf16x8*)(lds + PG8_SA(b, h) + aoff + m * 2048 + k * 1024); } } } while (0)
#define PG8_LDB(dst, b, h) do { _Pragma("unroll") for (int n = 0; n < 2; ++n) { if constexpr (FP8) dst##8[n] = cat8(*(const LAS bf16x8*)(lds + PG8_SB(b, h) + boff + n * 2048), *(const LAS bf16x8*)(lds + PG8_SB(b, h) + boff + n * 2048 + 1024)); \
        else { _Pragma("unroll") for (int k = 0; k < 2; ++k) dst[n][k] = *(const LAS bf16x8*)(lds + PG8_SB(b, h) + boff + n * 2048 + k * 1024); } } } while (0)
#define PG8_MMA(ai, bj, At, Bt) do { __builtin_amdgcn_s_setprio(1); _Pragma("unroll") for (int m = 0; m < 4; ++m) _Pragma("unroll") for (int n = 0; n < 2; ++n) { \
        if constexpr (FP8) acc[ai][bj][m][n] = __builtin_amdgcn_mfma_scale_f32_16x16x128_f8f6f4(Bt##8[n], At##8[m], acc[ai][bj][m][n], 0, 0, 0, 0, 0, 0); \
        else if constexpr (MODE == 2) { _Pragma("unroll") for (int k = 0; k < 2; ++k) acc[ai][bj][m][n] = __builtin_bit_cast(f32x4, __builtin_amdgcn_mfma_i32_16x16x64_i8(__builtin_bit_cast(i32x4, Bt[n][k]), __builtin_bit_cast(i32x4, At[m][k]), __builtin_bit_cast(i32x4, acc[ai][bj][m][n]), 0, 0, 0)); } \
        else { _Pragma("unroll") for (int k = 0; k < 2; ++k) acc[ai][bj][m][n] = __builtin_amdgcn_mfma_f32_16x16x32_bf16(Bt[n][k], At[m][k], acc[ai][bj][m][n], 0, 0, 0); } } \
        __builtin_amdgcn_s_setprio(0); } while (0)
#define PG8_WAIT_V(n) asm volatile("s_waitcnt vmcnt(" #n ")" ::: "memory")
#define PG8_WAIT_L(n) asm volatile("s_waitcnt lgkmcnt(" #n ")" ::: "memory")
#define PG8_BAR __builtin_amdgcn_s_barrier()
#define PG8_SCHED __builtin_amdgcn_sched_barrier(0)
    Unit cur, nxt; int ui = 0;
    if (!S.next(0, cur)) return;
    f32x4 acc[2][2][4][2];
#pragma unroll
    for (int a = 0; a < 2; ++a)
#pragma unroll
        for (int b = 0; b < 2; ++b)
#pragma unroll
            for (int m = 0; m < 4; ++m)
#pragma unroll
                for (int n = 0; n < 2; ++n) acc[a][b][m][n] = (f32x4){0.f, 0.f, 0.f, 0.f};
    bf16x8 At[4][2], B0[2][2], B1[2][2]; i32x8 At8[4], B08[2], B18[2];
    const char* cA = (const char*)g.A + (size_t)cur.pm * tstep + (size_t)cur.k0 * kstep; const char* cB = (const char*)g.Bt + (size_t)cur.pn * tstep + (size_t)cur.k0 * kstep;
    S.a_ready(cur);
    if constexpr (SP2) {
        PG8_STAGE(PG8_SB(0, 0), cB, voffB); PG8_STAGE(PG8_SB(0, 1), cB + hstep, voffB); PG8_STAGE(PG8_SA(0, 0), cA, voffA); PG8_STAGE(PG8_SA(0, 1), cA + hstep, voffA);
        if (wr == 1) PG8_BAR;
        PG8_WAIT_V(2); PG8_BAR;
        PG8_STAGE(PG8_SB(1, 0), cB + kstep, voffB); PG8_STAGE(PG8_SA(1, 0), cA + kstep, voffA); PG8_STAGE(PG8_SB(1, 1), cB + hstep + kstep, voffB);
        PG8_WAIT_V(6); PG8_BAR;
    } else {
        PG8_STAGE(PG8_SB(0, 0), cB, voffB); PG8_STAGE(PG8_SA(0, 0), cA, voffA); PG8_STAGE(PG8_SB(0, 1), cB + hstep, voffB); PG8_STAGE(PG8_SA(0, 1), cA + hstep, voffA);
        if (wr == 1) PG8_BAR;
        PG8_WAIT_V(4); PG8_BAR;
        PG8_STAGE(PG8_SB(1, 0), cB + kstep, voffB); PG8_STAGE(PG8_SA(1, 0), cA + kstep, voffA); PG8_STAGE(PG8_SB(1, 1), cB + hstep + kstep, voffB);
        PG8_WAIT_V(6); PG8_BAR;
    }
    for (;;) {
        const bool has_next = S.next(ui + 1, nxt);
        const char* nA = has_next ? (const char*)g.A + (size_t)nxt.pm * tstep + (size_t)nxt.k0 * kstep : cA; const char* nB = has_next ? (const char*)g.Bt + (size_t)nxt.pn * tstep + (size_t)nxt.k0 * kstep : cB;
        const int nt = cur.nt;
        for (int t = 0; t < nt; t += 2) {
            if constexpr (Epi::PERM) asm volatile("" : "+v"(voffA[0]), "+v"(voffA[1]), "+v"(voffB[0]), "+v"(voffB[1])); else asm volatile("" : "+v"(voffA[0]), "+v"(voffA[1]));
            const bool last = (t == nt - 2);
            const char* a1 = cA + (size_t)(t + 1) * kstep;
            const char* a2 = last ? nA : cA + (size_t)(t + 2) * kstep; const char* b2 = last ? nB : cB + (size_t)(t + 2) * kstep;
            const char* a3 = a2 + kstep; const char* b3 = b2 + kstep;
            if (last && has_next) S.a_ready(nxt);
            if constexpr (SP2) {
            PG8_LDB(B0, 0, 0); PG8_LDB(B1, 0, 1); PG8_SCHED; PG8_LDA(At, 0, 0); PG8_STAGE(PG8_SA(1, 1), a1 + hstep, voffA);
            PG8_WAIT_V(8); PG8_WAIT_L(0); PG8_BAR; PG8_MMA(0, 0, At, B0); PG8_MMA(0, 1, At, B1); PG8_BAR; PG8_SCHED;
            PG8_LDA(At, 0, 1); PG8_STAGE(PG8_SB(0, 0), b2, voffB); PG8_STAGE(PG8_SB(0, 1), b2 + hstep, voffB); PG8_STAGE(PG8_SA(0, 0), a2, voffA);
            PG8_WAIT_V(8); PG8_WAIT_L(0); PG8_BAR; PG8_MMA(1, 0, At, B0); PG8_MMA(1, 1, At, B1); PG8_BAR; PG8_SCHED;
            PG8_LDB(B0, 1, 0); PG8_LDB(B1, 1, 1); PG8_SCHED; PG8_LDA(At, 1, 0); PG8_STAGE(PG8_SA(0, 1), a2 + hstep, voffA);
            PG8_WAIT_V(8); PG8_WAIT_L(0); PG8_BAR; PG8_MMA(0, 0, At, B0); PG8_MMA(0, 1, At, B1); PG8_BAR; PG8_SCHED;
            PG8_LDA(At, 1, 1); PG8_STAGE(PG8_SB(1, 0), b3, voffB); PG8_STAGE(PG8_SB(1, 1), b3 + hstep, voffB); PG8_STAGE(PG8_SA(1, 0), a3, voffA);
            PG8_WAIT_V(8); PG8_WAIT_L(0); PG8_BAR; PG8_MMA(1, 0, At, B0); PG8_MMA(1, 1, At, B1); PG8_BAR; PG8_SCHED;
            } else {
            PG8_LDB(B0, 0, 0); PG8_SCHED; PG8_LDA(At, 0, 0); PG8_STAGE(PG8_SA(1, 1), a1 + hstep, voffA);
            PG8_WAIT_L(8); PG8_BAR; PG8_WAIT_L(0); PG8_MMA(0, 0, At, B0); PG8_BAR; PG8_SCHED;
            PG8_LDB(B1, 0, 1); PG8_STAGE(PG8_SB(0, 0), b2, voffB);
            PG8_BAR; PG8_WAIT_L(0); PG8_MMA(0, 1, At, B1); PG8_BAR;
            PG8_LDA(At, 0, 1); PG8_STAGE(PG8_SA(0, 0), a2, voffA);
            PG8_BAR; PG8_WAIT_L(0); PG8_MMA(1, 0, At, B0); PG8_BAR; PG8_SCHED;
            PG8_STAGE(PG8_SB(0, 1), b2 + hstep, voffB);
            PG8_WAIT_V(6); PG8_BAR; PG8_MMA(1, 1, At, B1); PG8_BAR;
            PG8_LDB(B0, 1, 0); PG8_SCHED; PG8_LDA(At, 1, 0); PG8_STAGE(PG8_SA(0, 1), a2 + hstep, voffA);
            PG8_WAIT_L(8); PG8_BAR; PG8_WAIT_L(0); PG8_MMA(0, 0, At, B0); PG8_BAR; PG8_SCHED;
            PG8_LDB(B1, 1, 1); PG8_STAGE(PG8_SB(1, 0), b3, voffB);
            PG8_BAR; PG8_WAIT_L(0); PG8_MMA(0, 1, At, B1); PG8_BAR;
            PG8_LDA(At, 1, 1); PG8_STAGE(PG8_SA(1, 0), a3, voffA);
            PG8_BAR; PG8_WAIT_L(0); PG8_MMA(1, 0, At, B0); PG8_BAR; PG8_SCHED;
            PG8_STAGE(PG8_SB(1, 1), b3 + hstep, voffB);
            PG8_WAIT_V(6); PG8_BAR; PG8_MMA(1, 1, At, B1); PG8_BAR;
            }
        }
        if constexpr (ALIGN_EPI) { if (wr == 0) PG8_BAR; }
        { const int te_ = lane_now(); E(acc, cur, wr, wc, te_ & 15, (te_ >> 4) & 3); } S.done(cur);
        if (!has_next) break;
#pragma unroll
        for (int a = 0; a < 2; ++a)
#pragma unroll
            for (int b = 0; b < 2; ++b)
#pragma unroll
                for (int m = 0; m < 4; ++m)
#pragma unroll
                    for (int n = 0; n < 2; ++n) acc[a][b][m][n] = (f32x4){0.f, 0.f, 0.f, 0.f};
        cur = nxt; cA = nA; cB = nB; ++ui;
        if constexpr (ALIGN_EPI) { if (wr == 1) PG8_BAR; }
    }
    PG8_WAIT_V(0);
    if constexpr (!ALIGN_EPI) { if (wr == 0) PG8_BAR; }
    PG8_BAR;
#undef PG8_SA
#undef PG8_SB
#undef PG8_STAGE
#undef PG8_LDA
#undef PG8_LDB
#undef PG8_MMA
#undef PG8_WAIT_V
#undef PG8_WAIT_L
#undef PG8_BAR
#undef PG8_SCHED
}
}

constexpr int LDS_BYTES = 160 * 1024;
constexpr int MISC_OFF = LDS_BYTES - 256;
constexpr int L_QS = 0, L_KK = 17408, L_VBT = 34816, L_KBGT = 53248, L_MS = 71680, L_ATT = 88064, L_KDT = 97280, L_TT = 115712, L_SM = 124928, L_UT = 125952, L_RED = 144384;
constexpr int L_W = L_KK, L_ST = 34816, L_VNT = 69632;
static_assert(L_VNT + IMG_VNT <= L_ATT && L_RED + 2048 <= MISC_OFF, "lds map");
constexpr int SC_STG = 35840, SC_ST = 71680, SC_VNT = 106496;
constexpr int OP_QD = 0, OP_ATT = 17408, OP_VNT = 26624, OP_H = 45056, OP_RED = 79872;
constexpr int LD128B = 272, LD64B = 144;

#define XB_TMO      128
#define XB_XCNT(j)  (256  + 64 * (j))
#define XB_XSUB(j)  (1280 + 64 * (j))
#define XB_XGEN(j)  (2304 + 64 * (j))
#define XB_TOP      3328
#define XB_TOPGEN   3392
#define XCD_BAR_WORDS 3456
#define XB_SPIN_CAP (1u << 22)
__device__ __forceinline__ unsigned xb_ld(unsigned* p)              { return __hip_atomic_load(p, __ATOMIC_RELAXED, __HIP_MEMORY_SCOPE_AGENT); }
__device__ __forceinline__ unsigned xb_add(unsigned* p, unsigned v) { return __hip_atomic_fetch_add(p, v, __ATOMIC_RELAXED, __HIP_MEMORY_SCOPE_AGENT); }
__device__ __forceinline__ unsigned xb_xcc_id() { return (unsigned)__builtin_amdgcn_s_getreg((3 << 11) | 20) & 0xFu; }
#define XB_SPIN(cond, bar) do { unsigned _sp = 0; while (cond) { __builtin_amdgcn_s_sleep(1); \
    if ((++_sp & 255u) == 0u) { if (xb_ld(&(bar)[XB_TMO])) break; if (_sp > XB_SPIN_CAP) { atomicAdd(&(bar)[XB_TMO], 1u); break; } } } } while (0)
struct XcdBarrier { unsigned* bar; unsigned x; volatile LAS unsigned* st; };
__device__ __forceinline__ XcdBarrier xcd_barrier_post(unsigned* bar, volatile LAS unsigned* st, const int wave_s) {
    XcdBarrier b; b.bar = bar; b.x = xb_xcc_id(); b.st = st;
    if (TID_NOW(wave_s) == 0) (void)xb_add(&bar[XB_XCNT(b.x)], 1u);
    return b;
}
__device__ __forceinline__ void xcd_barrier_complete(unsigned* bar, unsigned x, unsigned& nloc, unsigned& nx) {
    const unsigned G = gridDim.x * gridDim.y * gridDim.z;
    unsigned sum, cnt, mine, sp = 0u;
    for (;;) {
        sum = 0u; cnt = 0u; mine = 0u;
#pragma unroll
        for (unsigned j = 0; j < 16; ++j) { const unsigned c = xb_ld(&bar[XB_XCNT(j)]); sum += c; cnt += (c > 0u) ? 1u : 0u; mine = (j == x) ? c : mine; }
        if (sum == G) break;
        __builtin_amdgcn_s_sleep(1);
        if ((++sp & 255u) == 0u) { if (xb_ld(&bar[XB_TMO])) break; if (sp > XB_SPIN_CAP) { atomicAdd(&bar[XB_TMO], 1u); break; } }
    }
    nloc = mine > 0u ? mine : 1u; nx = cnt > 0u ? cnt : 1u;
}
__device__ __forceinline__ void xcd_barrier(const XcdBarrier& b, const int wave_s) {
    asm volatile("s_waitcnt vmcnt(0)" ::: "memory");
    __syncthreads();
    if (TID_NOW(wave_s) == 0) {
        unsigned* bar = b.bar;
        __builtin_amdgcn_s_waitcnt(0);
        unsigned nloc = b.st[0], nx = b.st[1];
        if (nloc == 0u) { xcd_barrier_complete(bar, b.x, nloc, nx); b.st[0] = nloc; b.st[1] = nx; }
        const unsigned old = xb_add(&bar[XB_XSUB(b.x)], 1u);
        const unsigned gen = old / nloc;
        if (old + 1u == (gen + 1u) * nloc) {
            __builtin_amdgcn_fence(__ATOMIC_RELEASE, "agent");
            asm volatile("s_waitcnt vmcnt(0)" ::: "memory");
            const unsigned og = xb_add(&bar[XB_TOP], 1u);
            const unsigned tg = og / nx;
            if (og + 1u == (tg + 1u) * nx) xb_add(&bar[XB_TOPGEN], 1u);
            else XB_SPIN(xb_ld(&bar[XB_TOPGEN]) == tg, bar);
            __builtin_amdgcn_fence(__ATOMIC_ACQUIRE, "agent");
            xb_add(&bar[XB_XGEN(b.x)], 1u);
            asm volatile("s_waitcnt vmcnt(0)" ::: "memory");
        } else {
            XB_SPIN(xb_ld(&bar[XB_XGEN(b.x)]) == gen, bar);
            __builtin_amdgcn_fence(__ATOMIC_ACQUIRE, "agent");
            asm volatile("s_waitcnt vmcnt(0)" ::: "memory");
        }
    }
    __syncthreads();
}

struct Args { const float* in[20]; float* out; uchar* ws; int ph_lo, ph_hi; };

#define STG_T0() ((void)0)
#define STG(n) ((void)0)
#define PROBE_STAGE 0
struct Frame {
    LAS uchar* lds;
    int tid, lane, wave, vcu, G;
    const GAS float* const* in; GAS float* out; GAS uchar* ws;
};
constexpr int I_XP = 0, I_XS = 1, I_SCA = 2, I_SGC = 3, I_SG = 4, I_WIN = 5, I_CAW = 6, I_GCW = 7, I_ALOG = 8, I_DTB = 9, I_GNW = 10, I_WA = 11, I_WB = 12, I_WO = 13,
              I_L1G = 14, I_L1B = 15, I_WUP = 16, I_WD = 17, I_L2G = 18, I_L2B = 19;

struct TrJob { const GAS float* W; GAS bf16_t* WT; int K, ldw, row_off, nblk; float fp8; GAS uchar* WT8; };
__device__ __forceinline__ void tr_load(const TrJob& j, int item, int lane, f32x4 (&v)[8]) {
    const int kb = item / j.nblk, nb = item - kb * j.nblk; const GAS float* src = j.W + (size_t)(64 * kb + (lane >> 3)) * j.ldw + 32 * nb + 4 * (lane & 7);
#pragma unroll
    for (int i = 0; i < 8; ++i) v[i] = *(const GAS f32x4*)(src + (size_t)(8 * i) * j.ldw);
}
__device__ __forceinline__ void tr_store(const TrJob& j, int item, int lane, const f32x4 (&v)[8], LAS float* scr) {
    const int kb = item / j.nblk, nb = item - kb * j.nblk, k0 = 64 * kb, n0 = 32 * nb;
#pragma unroll
    for (int i = 0; i < 8; ++i) { LAS float* d = scr + (8 * i + (lane >> 3)) * 33 + 4 * (lane & 7); d[0] = v[i][0]; d[1] = v[i][1]; d[2] = v[i][2]; d[3] = v[i][3]; }
    LDS_WAIT(); asm volatile("" ::: "memory");
    const int c = lane & 7;
#pragma unroll
    for (int jj = 0; jj < 4; ++jj) { const int n = (lane >> 3) + 8 * jj; const LAS float* sp = scr + (8 * c) * 33 + n;
        if (j.fp8 < 0.f) { const float sc = -j.fp8;
            *(GAS u32x2*)((GAS uchar*)j.WT + (size_t)(j.row_off + n0 + n) * j.K + k0 + 8 * c) = (u32x2){pk4_i8(sp[0 * 33] * sc, sp[1 * 33] * sc, sp[2 * 33] * sc, sp[3 * 33] * sc), pk4_i8(sp[4 * 33] * sc, sp[5 * 33] * sc, sp[6 * 33] * sc, sp[7 * 33] * sc)};
        } else if (j.fp8 > 0.f) { const float sc = j.fp8;
            *(GAS u32x2*)((GAS uchar*)j.WT + (size_t)(j.row_off + n0 + n) * j.K + k0 + 8 * c) = (u32x2){pk4_fp8(sp[0 * 33] * sc, sp[1 * 33] * sc, sp[2 * 33] * sc, sp[3 * 33] * sc), pk4_fp8(sp[4 * 33] * sc, sp[5 * 33] * sc, sp[6 * 33] * sc, sp[7 * 33] * sc)};
        } else {
        u32x4 o; o.x = pk2(sp[0 * 33], sp[1 * 33]); o.y = pk2(sp[2 * 33], sp[3 * 33]); o.z = pk2(sp[4 * 33], sp[5 * 33]); o.w = pk2(sp[6 * 33], sp[7 * 33]);
        *(GAS u32x4*)(j.WT + (size_t)(j.row_off + n0 + n) * j.K + k0 + 8 * c) = o;
        if (j.WT8) { const float sc = pg8::WIN_SCALE;
            *(GAS u32x2*)(j.WT8 + (size_t)(j.row_off + n0 + n) * j.K + k0 + 8 * c) = (u32x2){pk4_i8(sp[0 * 33] * sc, sp[1 * 33] * sc, sp[2 * 33] * sc, sp[3 * 33] * sc), pk4_i8(sp[4 * 33] * sc, sp[5 * 33] * sc, sp[6 * 33] * sc, sp[7 * 33] * sc)}; } } }
    LDS_WAIT(); asm volatile("" ::: "memory");
}
__device__ __forceinline__ TrJob tr_job(Frame& F, int l, int it, int& r) {
    constexpr int J0 = 32 * 224, J1 = 32 * 128, J2 = 16 * 64, J3 = 16 * 64, J4 = 32 * 64, J5 = 32 * 256;
    const GAS float* win = F.in[I_WIN] + (size_t)l * DM * NPROJ_REF;
    r = it;
    if (r < J0) return TrJob{win, (GAS bf16_t*)(F.ws + WS_WIN), DM, NPROJ_REF, 0, 224, 0.f, F.ws + WS_WIN8}; r -= J0;
    if (r < J1) return TrJob{win + 7184, (GAS bf16_t*)(F.ws + WS_WIN), DM, NPROJ_REF, 7168, 128, 0.f, F.ws + WS_WIN8}; r -= J1;
    if (r < J2) return TrJob{F.in[I_WA] + (size_t)l * DCONV * DM, (GAS bf16_t*)(F.ws + WS_WA), DCONV, DM, 0, 64, 0.f, nullptr}; r -= J2;
    if (r < J3) return TrJob{F.in[I_WB] + (size_t)l * DGDN * DM, (GAS bf16_t*)(F.ws + WS_WB), DGDN, DM, 0, 64, 0.f, nullptr}; r -= J3;
    if (r < J4) return TrJob{F.in[I_WO] + (size_t)l * DM * DM, (GAS bf16_t*)(F.ws + WS_WO), DM, DM, 0, 64, -pg8::WO_SCALE, nullptr}; r -= J4;
    if (r < J5) return TrJob{F.in[I_WUP] + (size_t)l * DM * DFF, (GAS bf16_t*)(F.ws + WS_WUP), DM, DFF, 0, 256, -pg8::WUP_SCALE, nullptr}; r -= J5;
    return TrJob{F.in[I_WD] + (size_t)l * DFF * DM, (GAS bf16_t*)(F.ws + WS_WD), DFF, DM, 0, 64, -pg8::WD_SCALE, nullptr};
}
__device__ __forceinline__ void phase_conv(Frame& F, int l) {
    LAS float* scr = (LAS float*)(F.lds + F.wave * 16384);
    const int gw = F.vcu * 8 + F.wave, NGW = F.G * 8;
    const GAS float* win = F.in[I_WIN] + (size_t)l * DM * NPROJ_REF;
    constexpr int NITEMS = 32 * 224 + 32 * 128 + 16 * 64 + 16 * 64 + 32 * 64 + 32 * 256 + 128 * 64;
    {
        f32x4 va[8], vb[8]; int it = gw, ra = 0, rb = 0; TrJob ja{}, jb{};
        if (it < NITEMS) { ja = tr_job(F, l, it, ra); tr_load(ja, ra, F.lane, va); }
        while (it < NITEMS) {
            const int nx = it + NGW;
            if (nx < NITEMS) { jb = tr_job(F, l, nx, rb); tr_load(jb, rb, F.lane, vb); }
            tr_store(ja, ra, F.lane, va, scr);
            it = nx; if (it >= NITEMS) break;
            const int nx2 = it + NGW;
            if (nx2 < NITEMS) { ja = tr_job(F, l, nx2, ra); tr_load(ja, ra, F.lane, va); }
            tr_store(jb, rb, F.lane, vb, scr);
            it = nx2;
        }
    }
    { GAS float* wlg = (GAS float*)(F.ws + WS_WLG); const int gt = F.vcu * 512 + F.tid, NT = F.G * 512;
      for (int e = gt; e < 16 * DM; e += NT) { const int j = e & 15, k = e >> 4; wlg[j * DM + k] = win[(size_t)k * NPROJ_REF + 7168 + j]; } }
    if (l == 0) {
        GAS bf16_t* xb = (GAS bf16_t*)(F.ws + WS_XB);
        for (int m = gw; m < MT; m += NGW) {
            const GAS float* xr = (m < MP) ? F.in[I_XP] + (size_t)m * DM : F.in[I_XS] + (size_t)(m - MP) * DM;
#pragma unroll
            for (int j = 0; j < 4; ++j) { const f32x4 a = *(const GAS f32x4*)(xr + j * 512 + F.lane * 8), b = *(const GAS f32x4*)(xr + j * 512 + F.lane * 8 + 4);
                u32x4 o; o.x = pk2(a[0], a[1]); o.y = pk2(a[2], a[3]); o.z = pk2(b[0], b[1]); o.w = pk2(b[2], b[3]);
                *(GAS u32x4*)(xb + (size_t)m * DM + j * 512 + F.lane * 8) = o;
                const float sq = pg8::XQ_SCALE;
                *(GAS u32x2*)(F.ws + WS_XB8 + (size_t)m * DM + j * 512 + F.lane * 8) = (u32x2){pk4_i8(a[0] * sq, a[1] * sq, a[2] * sq, a[3] * sq), pk4_i8(b[0] * sq, b[1] * sq, b[2] * sq, b[3] * sq)}; }
        }
    }
}

__device__ __forceinline__ void phase_logits(Frame& F, int l) {
    const int gw = F.vcu * 8 + F.wave, NGW = F.G * 8;
    const GAS float* wlg = (const GAS float*)(F.ws + WS_WLG); GAS float* lg = (GAS float*)(F.ws + WS_LG);
    for (int m0 = 4 * gw; m0 < MT; m0 += 4 * NGW) {
        const GAS float* xr = (l == 0) ? ((m0 < MP) ? F.in[I_XP] + (size_t)m0 * DM : F.in[I_XS] + (size_t)(m0 - MP) * DM) : (const GAS float*)(F.ws + WS_X) + (size_t)m0 * DM;
        float acc[4][16];
#pragma unroll
        for (int r = 0; r < 4; ++r)
#pragma unroll
            for (int j = 0; j < 16; ++j) acc[r][j] = 0.f;
#pragma unroll 1
        for (int kk = 0; kk < 8; ++kk) { const int k = kk * 256 + F.lane * 4; f32x4 xv[4];
#pragma unroll
            for (int r = 0; r < 4; ++r) xv[r] = *(const GAS f32x4*)(xr + (size_t)r * DM + k);
#pragma unroll
            for (int j = 0; j < 16; ++j) { const f32x4 wv = *(const GAS f32x4*)(wlg + j * DM + k);
#pragma unroll
                for (int r = 0; r < 4; ++r) acc[r][j] += xv[r][0] * wv[0] + xv[r][1] * wv[1] + xv[r][2] * wv[2] + xv[r][3] * wv[3]; } }
        float mine = 0.f;
#pragma unroll
        for (int r = 0; r < 4; ++r)
#pragma unroll
            for (int j = 0; j < 16; ++j) { const float sm_ = wave_sum(acc[r][j]); if (F.lane == r * 16 + j) mine = sm_; }
        lg[(size_t)m0 * 16 + F.lane] = mine;
    }
}

__device__ __forceinline__ void mixa_unit(Frame& F, int l, int u) {
    const GAS bf16_t* P = (const GAS bf16_t*)(F.ws + WS_P); GAS bf16_t* ain = (GAS bf16_t*)(F.ws + WS_AIN);
    const int c = 2 * F.tid;
    const GAS float* cw = F.in[I_CAW] + (size_t)l * 3 * DCONV;
    const f32x2 w0 = *(const GAS f32x2*)(cw + c), w1 = *(const GAS f32x2*)(cw + DCONV + c), w2 = *(const GAS f32x2*)(cw + 2 * DCONV + c);
    f32x2 um2 = {0.f, 0.f}, um1 = {0.f, 0.f};
    int row0, nrows; GAS float* so; int so_first;
    if (u < 256) { const int b = u >> 6, blk = u & 63; row0 = b * SEQ + blk * 32; nrows = 32;
        if (blk > 0) {
#pragma unroll
            for (int r = 0; r < 2; ++r) { const GAS bf16_t* pr = P + (size_t)(row0 - 2 + r) * NPROJ; const unsigned gc = *(const GAS unsigned*)(pr + CC + c), hh = *(const GAS unsigned*)(pr + CHH + c);
                const f32x2 uu = {bflo(gc) * bflo(hh), bfhi(gc) * bfhi(hh)}; if (r == 0) um2 = uu; else um1 = uu; } }
        so = (blk == 63) ? F.out + O_CAP + (size_t)((l * NPB + b) * 2) * DCONV : nullptr; so_first = 30;
    } else { const int b = u - 256; row0 = MP + b * SSEQ; nrows = SSEQ;
        const GAS float* st = F.in[I_SCA] + (size_t)((l * NSB + b) * 2) * DCONV;
        um2 = *(const GAS f32x2*)(st + c); um1 = *(const GAS f32x2*)(st + DCONV + c);
        so = F.out + O_CAS + (size_t)((l * NSB + b) * 2) * DCONV; so_first = 2;
    }
#pragma unroll 2
    for (int t0 = 0; t0 < nrows; t0 += 4) {
        unsigned gb[4], gc[4], hh[4];
#pragma unroll
        for (int j = 0; j < 4; ++j) { const GAS bf16_t* pr = P + (size_t)(row0 + t0 + j) * NPROJ;
            gb[j] = *(const GAS unsigned*)(pr + CB + c); gc[j] = *(const GAS unsigned*)(pr + CC + c); hh[j] = *(const GAS unsigned*)(pr + CHH + c); }
#pragma unroll
        for (int j = 0; j < 4; ++j) { const int t = t0 + j;
            const f32x2 uu = {bflo(gc[j]) * bflo(hh[j]), bfhi(gc[j]) * bfhi(hh[j])};
            const f32x2 cv = w0 * um2 + w1 * um1 + w2 * uu;
            *(GAS unsigned*)(ain + (size_t)(row0 + t) * DCONV + c) = pk2(bflo(gb[j]) * cv[0], bfhi(gb[j]) * cv[1]);
            if (so && t >= so_first) *(GAS f32x2*)(so + (size_t)(t - so_first) * DCONV + c) = uu;
            um2 = um1; um1 = uu; }
    }
}

struct PrepIn { int l, h, row0, nvalid, halo_mode  ; const GAS float* hs; GAS float* gc_out; int gc_i0; };
template <int NI>
__device__ __forceinline__ void gdn_prepare(Frame& F, const PrepIn& q) {
    LAS uchar* lds = F.lds; const int lane = F.lane, wave = F.wave, fr = lane & 15, fq = lane >> 4;
    const GAS bf16_t* P = (const GAS bf16_t*)(F.ws + WS_P);
    LAS float* sm = (LAS float*)(lds + L_SM);
    STG_T0();
    if (wave == 0) {
        const int i = lane; float g = 0.f, beta = 0.f;
        if (i < q.nvalid) { const GAS float* lgp = (const GAS float*)(F.ws + WS_LG) + (size_t)(q.row0 + i) * 16;
            const float bl = lgp[q.h], al = lgp[8 + q.h];
            beta = sigmoidf_(bl);
            const float xx = al + F.in[I_DTB][q.l * NH + q.h]; const float sp = softplusf_(xx);
            g = -__expf(F.in[I_ALOG][q.l * NH + q.h]) * sp; }
        float gc = g;
#pragma unroll
        for (int o = 1; o < 64; o <<= 1) { const float t = __builtin_bit_cast(float, __builtin_amdgcn_ds_bpermute(4 * (lane - o), __builtin_bit_cast(int, gc))); if (lane >= o) gc += t; }
        sm[i] = beta; sm[64 + i] = gc; if (i == 63) sm[128] = gc;
    }
    LBAR(); STG(1);
    {
        const int i0 = 8 * wave; const GAS float* cwb = F.in[I_GCW] + (size_t)q.l * 4 * 3 * DGDN;
        const bool st_halo = (q.halo_mode == 2) && (i0 == 0);
        unsigned raw3[3][11]; f32x2 hal3[3][3]; f32x2 cw3[3][4];
#pragma unroll
        for (int s = 0; s < 3; ++s) {
            const int chan = s * DGDN + q.h * HD + 2 * lane, pcol = CQ + chan;
#pragma unroll
            for (int j = 0; j < 4; ++j) cw3[s][j] = *(const GAS f32x2*)(cwb + (size_t)j * 3 * DGDN + chan);
#pragma unroll
            for (int r = 0; r < 11; ++r) { const int i = i0 - 3 + r; const bool ok = (i >= 0) ? (i < q.nvalid) : (q.halo_mode == 1);
                const int rowi = (q.row0 + i) < 0 ? 0 : (q.row0 + i);
                const unsigned w_ = *(const GAS unsigned*)(P + (size_t)rowi * NPROJ + pcol); raw3[s][r] = ok ? w_ : 0u; }
#pragma unroll
            for (int r = 0; r < 3; ++r) { hal3[s][r] = (f32x2){0.f, 0.f}; if (st_halo) hal3[s][r] = *(const GAS f32x2*)(q.hs + (size_t)r * 3 * DGDN + chan); }
        }
#pragma unroll
        for (int s = 0; s < 3; ++s) {
            const int chan = s * DGDN + q.h * HD + 2 * lane;
            f32x2 cw[4]; unsigned raw[11]; f32x2 hal[3];
#pragma unroll
            for (int j = 0; j < 4; ++j) cw[j] = cw3[s][j];
#pragma unroll
            for (int r = 0; r < 11; ++r) raw[r] = raw3[s][r];
#pragma unroll
            for (int r = 0; r < 3; ++r) hal[r] = hal3[s][r];
            f32x2 xv[11];
#pragma unroll
            for (int r = 0; r < 11; ++r) { xv[r] = (f32x2){bflo(raw[r]), bfhi(raw[r])}; if (r < 3 && st_halo) xv[r] = hal[r]; }
            if (q.gc_out) {
#pragma unroll
                for (int r = 3; r < 11; ++r) { const int i = i0 - 3 + r; if (i >= q.gc_i0 && i < q.gc_i0 + 3) *(GAS f32x2*)(q.gc_out + (size_t)(i - q.gc_i0) * 3 * DGDN + chan) = xv[r]; } }
            unsigned prev = 0u;
#pragma unroll
            for (int rr = 0; rr < 8; ++rr) {
                const int i = i0 + rr;
                f32x2 y = cw[0] * xv[rr] + cw[1] * xv[rr + 1] + cw[2] * xv[rr + 2] + cw[3] * xv[rr + 3];
                y[0] = siluf_(y[0]); y[1] = siluf_(y[1]);
                if (i >= q.nvalid) y = (f32x2){0.f, 0.f};
                const float beta = sm[i], gc = sm[64 + i];
                if (s == 0) { const float ss = wave_sum(y[0] * y[0] + y[1] * y[1]); const float rn = rsqrtf(ss + NORM_EPS) * 0.08838834764831845f;
                    *(LAS unsigned*)(lds + L_QS + i * LD128B + 4 * lane) = pk2(y[0] * rn, y[1] * rn); }
                else if (s == 1) { const float ss = wave_sum(y[0] * y[0] + y[1] * y[1]); const float rn = rsqrtf(ss + NORM_EPS);
                    const float k0 = y[0] * rn, k1 = y[1] * rn;
                    *(LAS unsigned*)(lds + L_KK + i * LD128B + 4 * lane) = pk2(k0, k1);
                    const float sc = beta * __expf(gc); const unsigned cur = pk2(k0 * sc, k1 * sc);
                    if (rr & 1) { *(LAS unsigned*)(lds + L_KBGT + (2 * lane) * LD64B + 2 * (i - 1)) = (prev & 0xffffu) | (cur << 16);
                                  *(LAS unsigned*)(lds + L_KBGT + (2 * lane + 1) * LD64B + 2 * (i - 1)) = (prev >> 16) | (cur & 0xffff0000u); }
                    prev = cur; }
                else { const unsigned cur = pk2(y[0] * beta, y[1] * beta);
                    if (rr & 1) { *(LAS unsigned*)(lds + L_VBT + (2 * lane) * LD64B + 2 * (i - 1)) = (prev & 0xffffu) | (cur << 16);
                                  *(LAS unsigned*)(lds + L_VBT + (2 * lane + 1) * LD64B + 2 * (i - 1)) = (prev >> 16) | (cur & 0xffff0000u); }
                    prev = cur; }
            }
        }
    }
    LBAR(); STG(2);
    for (int job = wave; job < 32; job += 8) {
        const bool isM = job < 16; const int jj = job & 15, ti = jj >> 2, tj = jj & 3;
        if (tj > ti) { if (!isM) {
#pragma unroll
                for (int reg = 0; reg < 4; ++reg) *(LAS bf16_t*)(lds + L_ATT + (16 * ti + 4 * fq + reg) * LD64B + 2 * (16 * tj + fr)) = (bf16_t)0; }
            continue; }
        f32x4 acc = {0.f, 0.f, 0.f, 0.f};
        const int abase = (isM ? L_KK : L_QS) + (16 * ti + fr) * LD128B + 16 * fq, bbase = L_KK + (16 * tj + fr) * LD128B + 16 * fq;
#pragma unroll
        for (int kk = 0; kk < 4; ++kk) { const bf16x8 a = *(const LAS bf16x8*)(lds + abase + kk * 64), b = *(const LAS bf16x8*)(lds + bbase + kk * 64);
            acc = __builtin_amdgcn_mfma_f32_16x16x32_bf16(a, b, acc, 0, 0, 0); }
        const int j = 16 * tj + fr; const float gcj = sm[64 + j];
#pragma unroll
        for (int reg = 0; reg < 4; ++reg) { const int i = 16 * ti + 4 * fq + reg; const float gci = sm[64 + i];
            const float d = (i >= j) ? __expf(gci - gcj) : 0.f;
            if (isM) *(LAS float*)(lds + L_MS + (i * 64 + j) * 4) = (i > j) ? sm[i] * acc[reg] * d : 0.f;
            else *(LAS bf16_t*)(lds + L_ATT + i * LD64B + 2 * j) = (bf16_t)(pk2(acc[reg] * d, 0.f) & 0xffffu); }
    }
    LBAR(); STG(3);
    constexpr int L_CB = L_UT, L_AT = L_UT + 2560, L_XT = L_UT + 5120, LDC = 80;
    if (wave == 0) {
        if constexpr (NI == 64) {
            float Tc[32]; int lv = lane & 31; const int hb = lane >> 5, rb = 32 * hb;
            const LAS uchar* msb = lds + L_MS + (rb * 64 + rb) * 4; asm volatile("" : "+v"(msb));
            LAS uchar* ttb = lds + L_TT + rb * LD64B + 2 * (rb + (lane & 31)); asm volatile("" : "+v"(ttb));
            LAS uchar* atb = lds + L_AT + (lane & 31) * LDC; asm volatile("" : "+v"(atb));
#pragma unroll
            for (int i = 0; i < 32; ++i) {
                float a0 = 0.f, a1 = 0.f, a2 = 0.f, a3 = 0.f;
#pragma unroll
                for (int m4 = 0; m4 < i; m4 += 4) { const f32x4 mv = *(const LAS f32x4*)(msb + (i * 64 + m4) * 4);
                    a0 += mv[0] * Tc[m4]; if (m4 + 1 < i) a1 += mv[1] * Tc[m4 + 1]; if (m4 + 2 < i) a2 += mv[2] * Tc[m4 + 2]; if (m4 + 3 < i) a3 += mv[3] * Tc[m4 + 3]; }
                asm volatile("" : "+v"(lv));
                Tc[i] = (i == lv) ? 1.f : -((a0 + a1) + (a2 + a3));
                const bf16_t tb = (bf16_t)(pk2(Tc[i], 0.f) & 0xffffu);
                *(LAS bf16_t*)(ttb + i * LD64B) = tb;
                if (hb == 0) *(LAS bf16_t*)(atb + 2 * i) = tb;
                if ((i & 3) == 3) asm volatile("" ::: "memory");
            }
        } else {
            float Tc[NI]; int lv = lane;
            const LAS uchar* msb = lds + L_MS; asm volatile("" : "+v"(msb));
            LAS uchar* ttb = lds + L_TT + 2 * lane; asm volatile("" : "+v"(ttb));
#pragma unroll
            for (int i = 0; i < NI; ++i) { float a = 0.f;
#pragma unroll
                for (int m = 0; m < i; ++m) a += *(const LAS float*)(msb + (i * 64 + m) * 4) * Tc[m];
                asm volatile("" : "+v"(lv)); Tc[i] = (i == lv) ? 1.f : -a;
                *(LAS bf16_t*)(ttb + i * LD64B) = (bf16_t)(pk2(Tc[i], 0.f) & 0xffffu); }
#pragma unroll 1
            for (int i = NI; i < 64; ++i) *(LAS bf16_t*)(lds + L_TT + i * LD64B + 2 * lane) = (i == lane) ? (bf16_t)0x3f80 : (bf16_t)0;
        }
    } else {
        const int t = F.tid - 64; const float glast = sm[128];
        for (int idx = t; idx < 64 * 64; idx += 448) { const int i = idx >> 6, p = idx & 63; const float e = __expf(sm[64 + i]);
            LAS unsigned* a = (LAS unsigned*)(lds + L_QS + i * LD128B + 4 * p); const unsigned w = *a; *a = pk2(bflo(w) * e, bfhi(w) * e); }
        for (int idx = t; idx < 128 * 32; idx += 448) { const int d = idx & 127, ip = idx >> 7, i = 2 * ip;
            const float k0 = bf1(*(const LAS bf16_t*)(lds + L_KK + i * LD128B + 2 * d)), k1 = bf1(*(const LAS bf16_t*)(lds + L_KK + (i + 1) * LD128B + 2 * d));
            *(LAS unsigned*)(lds + L_KDT + d * LD64B + 4 * ip) = pk2(k0 * __expf(glast - sm[64 + i]), k1 * __expf(glast - sm[65 + i])); }
        if constexpr (NI == 64) {
            for (int idx = t; idx < 32 * 16; idx += 448) { const int i = idx >> 4, mp = idx & 15;
                const f32x2 c2 = *(const LAS f32x2*)(lds + L_MS + ((32 + i) * 64 + 2 * mp) * 4);
                *(LAS unsigned*)(lds + L_CB + i * LDC + 4 * mp) = pk2(c2[0], c2[1]);
                *(LAS unsigned*)(lds + L_TT + i * LD64B + 2 * (32 + 2 * mp)) = 0u; }
        }
    }
    if constexpr (NI == 64) {
        LBAR();
        if (wave < 4) { const int ti = wave >> 1, tj = wave & 1;
            const bf16x8 a = *(const LAS bf16x8*)(lds + L_CB + (16 * ti + fr) * LDC + 16 * fq), b = *(const LAS bf16x8*)(lds + L_AT + (16 * tj + fr) * LDC + 16 * fq);
            const f32x4 x = __builtin_amdgcn_mfma_f32_16x16x32_bf16(a, b, (f32x4){0.f, 0.f, 0.f, 0.f}, 0, 0, 0);
            *(LAS u32x2*)(lds + L_XT + (16 * tj + fr) * LDC + 2 * (16 * ti + 4 * fq)) = (u32x2){pk2(x[0], x[1]), pk2(x[2], x[3])}; }
        LBAR();
        if (wave < 4) { const int ti = wave >> 1, tj = wave & 1;
            const bf16x8 a = *(const LAS bf16x8*)(lds + L_TT + (32 + 16 * ti + fr) * LD64B + 2 * 32 + 16 * fq), b = *(const LAS bf16x8*)(lds + L_XT + (16 * tj + fr) * LDC + 16 * fq);
            const f32x4 x = __builtin_amdgcn_mfma_f32_16x16x32_bf16(a, b, (f32x4){0.f, 0.f, 0.f, 0.f}, 0, 0, 0);
#pragma unroll
            for (int reg = 0; reg < 4; ++reg) *(LAS bf16_t*)(lds + L_TT + (32 + 16 * ti + 4 * fq + reg) * LD64B + 2 * (16 * tj + fr)) = (bf16_t)(pk2(-x[reg], 0.f) & 0xffffu); }
    }
    LBAR(); STG(4);
    for (int job = wave; job < 64; job += 8) {
        f32x4 acc = {0.f, 0.f, 0.f, 0.f};
        if (job < 32) { const int tc = job >> 3, tdv = job & 7;
#pragma unroll
            for (int kk = 0; kk < 2; ++kk) { const bf16x8 a = *(const LAS bf16x8*)(lds + L_TT + (16 * tc + fr) * LD64B + kk * 64 + 16 * fq), b = *(const LAS bf16x8*)(lds + L_VBT + (16 * tdv + fr) * LD64B + kk * 64 + 16 * fq);
                acc = __builtin_amdgcn_mfma_f32_16x16x32_bf16(a, b, acc, 0, 0, 0); }
            *(LAS u32x2*)(lds + L_UT + (16 * tdv + fr) * LD64B + 2 * (16 * tc + 4 * fq)) = (u32x2){pk2(acc[0], acc[1]), pk2(acc[2], acc[3])};
        } else { const int tdk = (job - 32) >> 2, tc = (job - 32) & 3;
#pragma unroll
            for (int kk = 0; kk < 2; ++kk) { const bf16x8 a = *(const LAS bf16x8*)(lds + L_KBGT + (16 * tdk + fr) * LD64B + kk * 64 + 16 * fq), b = *(const LAS bf16x8*)(lds + L_TT + (16 * tc + fr) * LD64B + kk * 64 + 16 * fq);
                acc = __builtin_amdgcn_mfma_f32_16x16x32_bf16(a, b, acc, 0, 0, 0); }
            *(LAS u32x2*)(lds + L_W + (16 * tc + fr) * LD128B + 2 * (16 * tdk + 4 * fq)) = (u32x2){pk2(acc[0], acc[1]), pk2(acc[2], acc[3])};
        }
    }
    LBAR(); STG(5);
}

__device__ __forceinline__ void gdn_step(const LAS uchar* pW, const LAS uchar* pKDT, const LAS uchar* pST, LAS uchar* pVNT, const f32x4 (&U)[4], f32x4 (&V)[4], f32x4 (&S)[8], float eg, int wave, int lane) {
    const int fr = lane & 15, fq = lane >> 4;
    bf16x8 bS[4], aW[4][4], aK[8][2];
#pragma unroll
    for (int kk = 0; kk < 4; ++kk) bS[kk] = *(const LAS bf16x8*)(pST + (16 * wave + fr) * LD128B + kk * 64 + 16 * fq);
#pragma unroll
    for (int tc = 0; tc < 4; ++tc)
#pragma unroll
        for (int kk = 0; kk < 4; ++kk) aW[tc][kk] = *(const LAS bf16x8*)(pW + (16 * tc + fr) * LD128B + kk * 64 + 16 * fq);
    f32x4 x[4];
#pragma unroll
    for (int tc = 0; tc < 4; ++tc) x[tc] = (f32x4){0.f, 0.f, 0.f, 0.f};
#pragma unroll
    for (int kk = 0; kk < 4; ++kk)
#pragma unroll
        for (int tc = 0; tc < 4; ++tc) x[tc] = __builtin_amdgcn_mfma_f32_16x16x32_bf16(aW[tc][kk], bS[kk], x[tc], 0, 0, 0);
#pragma unroll
    for (int t = 0; t < 8; ++t)
#pragma unroll
        for (int kk = 0; kk < 2; ++kk) aK[t][kk] = *(const LAS bf16x8*)(pKDT + (16 * t + fr) * LD64B + kk * 64 + 16 * fq);
#pragma unroll
    for (int tc = 0; tc < 4; ++tc) { V[tc] = U[tc] - x[tc];
        *(LAS u32x2*)(pVNT + (16 * wave + fr) * LD64B + 2 * (16 * tc + 4 * fq)) = (u32x2){pk2(V[tc][0], V[tc][1]), pk2(V[tc][2], V[tc][3])}; }
    bf16x8 bV[2];
#pragma unroll
    for (int kk = 0; kk < 2; ++kk) bV[kk] = *(const LAS bf16x8*)(pVNT + (16 * wave + fr) * LD64B + kk * 64 + 16 * fq);
#pragma unroll
    for (int t = 0; t < 8; ++t) S[t] = S[t] * eg;
#pragma unroll
    for (int kk = 0; kk < 2; ++kk)
#pragma unroll
        for (int t = 0; t < 8; ++t) S[t] = __builtin_amdgcn_mfma_f32_16x16x32_bf16(aK[t][kk], bV[kk], S[t], 0, 0, 0);
}

__device__ __forceinline__ void gdn_prompt_prepare_unit(Frame& F, int l, int u) {
    const int h = u & 7, c = (u >> 3) & 31, b = u >> 8;
    PrepIn q; q.l = l; q.h = h; q.row0 = b * SEQ + c * 64; q.nvalid = 64; q.halo_mode = (c > 0) ? 1 : 0; q.hs = nullptr;
    q.gc_out = (c == NCHUNK - 1) ? F.out + O_GCP + (size_t)((l * NPB + b) * 3) * 3 * DGDN : nullptr; q.gc_i0 = 61;
    gdn_prepare<64>(F, q);
    const LAS uchar* lds = F.lds;
    for (int p = F.tid; p < IMG_QD / 16; p += 512) *(GAS u32x4*)(F.ws + WS_GQD + (size_t)u * IMG_QD + 16 * p) = *(const LAS u32x4*)(lds + L_QS + 16 * p);
    for (int p = F.tid; p < IMG_W / 16; p += 512) *(GAS u32x4*)(F.ws + WS_GW + (size_t)u * IMG_W + 16 * p) = *(const LAS u32x4*)(lds + L_W + 16 * p);
    for (int p = F.tid; p < IMG_ATT / 16; p += 512) *(GAS u32x4*)(F.ws + WS_GATT + (size_t)u * IMG_ATT + 16 * p) = *(const LAS u32x4*)(lds + L_ATT + 16 * p);
    for (int p = F.tid; p < IMG_KDT / 16; p += 512) *(GAS u32x4*)(F.ws + WS_GKDT + (size_t)u * IMG_KDT + 16 * p) = *(const LAS u32x4*)(lds + L_KDT + 16 * p);
    for (int p = F.tid; p < IMG_UT / 16; p += 512) *(GAS u32x4*)(F.ws + WS_GUT + (size_t)u * IMG_UT + 16 * p) = *(const LAS u32x4*)(lds + L_UT + 16 * p);
    if (F.tid == 0) ((GAS float*)(F.ws + WS_GL))[u] = ((const LAS float*)(lds + L_SM))[128];
    LBAR();

}

__device__ __forceinline__ void gdn_sample_wave(Frame& F, int l, int base) {
    int t_ = F.tid; asm volatile("" : "+v"(t_));
    const int lane = t_ & 63, wave = __builtin_amdgcn_readfirstlane(t_ >> 6), hv = wave & 1; const int u_ = base + (wave >> 1); const bool act = u_ < NSB * NH; const int u = act ? u_ : 0;
    const int h = u & 7, b = u >> 3, row0 = MP + b * SSEQ;
    LAS uchar* wl = F.lds + wave * 8192;
    LAS float* exch = (LAS float*)(F.lds + 65536);
    const GAS bf16_t* P = (const GAS bf16_t*)(F.ws + WS_P);
    float beta[4], gc[4];
    { const GAS float* lgp = (const GAS float*)(F.ws + WS_LG) + (size_t)row0 * 16; const float dtb = F.in[I_DTB][l * NH + h], ea = __expf(F.in[I_ALOG][l * NH + h]); float run = 0.f;
#pragma unroll
      for (int t = 0; t < 4; ++t) { const float bl = lgp[t * 16 + h], al = lgp[t * 16 + 8 + h]; beta[t] = sigmoidf_(bl);
          const float xx = al + dtb; const float sp = softplusf_(xx); run += -ea * sp; gc[t] = run; } }
    const GAS float* hs = F.in[I_SGC] + (size_t)((l * NSB + b) * 3) * 3 * DGDN; const GAS float* cwb = F.in[I_GCW] + (size_t)l * 4 * 3 * DGDN;
    GAS float* gco = F.out + O_GCS + (size_t)((l * NSB + b) * 3) * 3 * DGDN;
    f32x2 q[4], k[4]; float v[4];
    {
        const int cq = h * HD + 2 * lane, ck = DGDN + cq, cv = 2 * DGDN + h * HD + 64 * hv + lane;
        f32x2 xq[7], xk[7]; float xv[7];
#pragma unroll
        for (int r = 0; r < 3; ++r) { xq[r] = *(const GAS f32x2*)(hs + (size_t)r * 3 * DGDN + cq); xk[r] = *(const GAS f32x2*)(hs + (size_t)r * 3 * DGDN + ck); xv[r] = hs[(size_t)r * 3 * DGDN + cv]; }
#pragma unroll
        for (int t = 0; t < 4; ++t) { const GAS bf16_t* pr = P + (size_t)(row0 + t) * NPROJ + CQ; const unsigned wq = *(const GAS unsigned*)(pr + cq), wk = *(const GAS unsigned*)(pr + ck);
            xq[3 + t] = (f32x2){bflo(wq), bfhi(wq)}; xk[3 + t] = (f32x2){bflo(wk), bfhi(wk)}; xv[3 + t] = bf1(pr[cv]); }
        if (act) {
#pragma unroll
            for (int t = 1; t < 4; ++t) { if (hv == 0) { *(GAS f32x2*)(gco + (size_t)(t - 1) * 3 * DGDN + cq) = xq[3 + t]; *(GAS f32x2*)(gco + (size_t)(t - 1) * 3 * DGDN + ck) = xk[3 + t]; }
                gco[(size_t)(t - 1) * 3 * DGDN + cv] = xv[3 + t]; } }
        f32x2 cwq[4], cwk[4]; float cwv[4];
#pragma unroll
        for (int j = 0; j < 4; ++j) { cwq[j] = *(const GAS f32x2*)(cwb + (size_t)j * 3 * DGDN + cq); cwk[j] = *(const GAS f32x2*)(cwb + (size_t)j * 3 * DGDN + ck); cwv[j] = cwb[(size_t)j * 3 * DGDN + cv]; }
#pragma unroll
        for (int t = 0; t < 4; ++t) {
            f32x2 yq = cwq[0] * xq[t] + cwq[1] * xq[t + 1] + cwq[2] * xq[t + 2] + cwq[3] * xq[t + 3];
            f32x2 yk = cwk[0] * xk[t] + cwk[1] * xk[t + 1] + cwk[2] * xk[t + 2] + cwk[3] * xk[t + 3];
            float yv = cwv[0] * xv[t] + cwv[1] * xv[t + 1] + cwv[2] * xv[t + 2] + cwv[3] * xv[t + 3];
            yq[0] = siluf_(yq[0]); yq[1] = siluf_(yq[1]);
            yk[0] = siluf_(yk[0]); yk[1] = siluf_(yk[1]);
            yv = siluf_(yv);
            const float sq = wave_sum(yq[0] * yq[0] + yq[1] * yq[1]), sk = wave_sum(yk[0] * yk[0] + yk[1] * yk[1]);
            q[t] = yq * (rsqrtf(sq + NORM_EPS) * 0.08838834764831845f); k[t] = yk * rsqrtf(sk + NORM_EPS); v[t] = yv;
        }
    }
    float T10, T20, T21, T30, T31, T32, at[4][4];
    {
        float kk[4][4], qk[4][4];
#pragma unroll
        for (int i = 0; i < 4; ++i)
#pragma unroll
            for (int j = 0; j <= i; ++j) { qk[i][j] = wave_sum(q[i][0] * k[j][0] + q[i][1] * k[j][1]); if (j < i) kk[i][j] = wave_sum(k[i][0] * k[j][0] + k[i][1] * k[j][1]); }
        float M[4][4];
#pragma unroll
        for (int i = 0; i < 4; ++i)
#pragma unroll
            for (int j = 0; j <= i; ++j) { const float d = __expf(gc[i] - gc[j]); at[i][j] = qk[i][j] * d; if (j < i) M[i][j] = beta[i] * kk[i][j] * d; }
        T10 = -M[1][0]; T21 = -M[2][1]; T32 = -M[3][2];
        T20 = -(M[2][0] + M[2][1] * T10); T31 = -(M[3][1] + M[3][2] * T21);
        T30 = -(M[3][0] + M[3][1] * T10 + M[3][2] * T20);
    }
    float uu[4];
    {
        float vb[4]; f32x2 kb[4];
#pragma unroll
        for (int m = 0; m < 4; ++m) { vb[m] = v[m] * beta[m]; kb[m] = k[m] * (beta[m] * __expf(gc[m])); }
        uu[0] = vb[0]; uu[1] = vb[1] + T10 * vb[0]; uu[2] = vb[2] + T20 * vb[0] + T21 * vb[1]; uu[3] = vb[3] + T30 * vb[0] + T31 * vb[1] + T32 * vb[2];
        f32x2 w[4]; w[0] = kb[0]; w[1] = kb[1] + T10 * kb[0]; w[2] = kb[2] + T20 * kb[0] + T21 * kb[1]; w[3] = kb[3] + T30 * kb[0] + T31 * kb[1] + T32 * kb[2];
        const float e0 = __expf(gc[0]), e1 = __expf(gc[1]), e2 = __expf(gc[2]), e3 = __expf(gc[3]);
        const float d0 = __expf(gc[3] - gc[0]), d1 = __expf(gc[3] - gc[1]), d2 = __expf(gc[3] - gc[2]);
#pragma unroll
        for (int e = 0; e < 2; ++e) { const int dk = 2 * lane + e;
            *(LAS f32x4*)(wl + dk * 16) = (f32x4){w[0][e], w[1][e], w[2][e], w[3][e]};
            *(LAS f32x4*)(wl + 2048 + dk * 16) = (f32x4){q[0][e] * e0, q[1][e] * e1, q[2][e] * e2, q[3][e] * e3};
            *(LAS f32x4*)(wl + 4096 + dk * 16) = (f32x4){k[0][e] * d0, k[1][e] * d1, k[2][e] * d2, k[3][e]}; }
    }
    const size_t soff = (size_t)((l * NSB + b) * NH + h) * HD * HD + 64 * hv + lane;
    const GAS float* s0 = F.in[I_SG] + soff; GAS float* s1 = F.out + O_GS + soff;
    float Sr[128];
    { const GAS float* p = s0;
#pragma unroll
      for (int c8 = 0; c8 < 16; ++c8) {
#pragma unroll
          for (int j = 0; j < 8; ++j) Sr[c8 * 8 + j] = p[j * HD];
          p += 8 * HD; asm volatile("" : "+v"(p)); } }
    float wS[4] = {0.f, 0.f, 0.f, 0.f}, qS[4] = {0.f, 0.f, 0.f, 0.f};
    const LAS uchar* wlb = wl; asm volatile("" : "+v"(wlb));
#pragma unroll
    for (int dk = 0; dk < 128; ++dk) { const f32x4 wv = *(const LAS f32x4*)(wlb + dk * 16), qv = *(const LAS f32x4*)(wlb + 2048 + dk * 16);
#pragma unroll
        for (int c = 0; c < 4; ++c) { fmac1(wS[c], wv[c], Sr[dk]); fmac1(qS[c], qv[c], Sr[dk]); }
        if ((dk & 3) == 3) asm volatile("" ::: "memory"); }
    float vn[4], o[4];
#pragma unroll
    for (int c = 0; c < 4; ++c) vn[c] = uu[c] - wS[c];
#pragma unroll
    for (int c = 0; c < 4; ++c) { float a = qS[c];
#pragma unroll
        for (int c2 = 0; c2 <= c; ++c2) a += at[c][c2] * vn[c2];
        o[c] = a; }
    const float eg = __expf(gc[3]);
    if (act) { GAS float* p = s1;
#pragma unroll
        for (int c8 = 0; c8 < 16; ++c8) {
#pragma unroll
            for (int j = 0; j < 8; ++j) { const int dk = c8 * 8 + j; const f32x4 kv = *(const LAS f32x4*)(wlb + 4096 + dk * 16);
                float r_ = Sr[dk] * eg; fmac1(r_, kv[0], vn[0]); fmac1(r_, kv[1], vn[1]); fmac1(r_, kv[2], vn[2]); fmac1(r_, kv[3], vn[3]); p[j * HD] = r_; }
            p += 8 * HD; asm volatile("" : "+v"(p) :: "memory"); }
    }
    float po[4];
#pragma unroll
    for (int c = 0; c < 4; ++c) po[c] = wave_sum(o[c] * o[c]);
    if (lane < 4) exch[wave * 4 + lane] = (lane == 0) ? po[0] : (lane == 1) ? po[1] : (lane == 2) ? po[2] : po[3];
    LBAR();
    const int dv = 64 * hv + lane; const float nw = F.in[I_GNW][l * HD + dv];
    GAS bf16_t* ob = (GAS bf16_t*)(F.ws + WS_OB);
#pragma unroll
    for (int c = 0; c < 4; ++c) { const float tot = po[c] + exch[(wave ^ 1) * 4 + c];
        const float z = bf1(P[(size_t)(row0 + c) * NPROJ + CZ + h * HD + dv]);
        const float r = o[c] * rsqrtf(tot * (1.f / HD) + NORM_EPS) * nw * siluf_(z);
        if (act) ob[(size_t)(row0 + c) * DGDN + h * HD + dv] = (bf16_t)(pk2(r, 0.f) & 0xffffu); }
    LBAR();
}

__device__ __forceinline__ void gdn_scan_unit(Frame& F, int l, int bh) {
    const int h = bh & 7, b = bh >> 3; const int lane = F.lane, wave = F.wave, fr = lane & 15, fq = lane >> 4, tid = F.tid;
    LAS uchar* lds = F.lds; const int dv = 16 * wave + fr;
    f32x4 S[8], U[4], V[4];
#pragma unroll
    for (int t = 0; t < 8; ++t) S[t] = (f32x4){0.f, 0.f, 0.f, 0.f};
    constexpr int NPIECE = (IMG_W + IMG_KDT) / 16;
    u32x4 preA[5], preB[5]; u32x2 UnA[4], UnB[4]; float glA = 0.f, glB = 0.f;
#define LOAD_STAGE(pre, uu) do { _Pragma("unroll") for (int k_ = 0; k_ < 5; ++k_) { const int p_ = tid + 512 * k_; \
            const GAS uchar* src_ = (p_ < IMG_W / 16) ? F.ws + WS_GW + (size_t)(uu) * IMG_W + 16 * p_ : F.ws + WS_GKDT + (size_t)(uu) * IMG_KDT + 16 * (p_ - IMG_W / 16); \
            if (p_ < NPIECE) pre[k_] = *(const GAS u32x4*)src_; } } while (0)
#define WRITE_STAGE(pre, buf) do { _Pragma("unroll") for (int k_ = 0; k_ < 5; ++k_) { const int p_ = tid + 512 * k_; if (p_ < NPIECE) *(LAS u32x4*)(lds + (buf) * SC_STG + 16 * p_) = pre[k_]; } } while (0)
#define LOAD_U(Un, gl, uu) do { _Pragma("unroll") for (int tc_ = 0; tc_ < 4; ++tc_) Un[tc_] = *(const GAS u32x2*)(F.ws + WS_GUT + (size_t)(uu) * IMG_UT + dv * LD64B + 2 * (16 * tc_ + 4 * fq)); \
        gl = ((const GAS float*)(F.ws + WS_GL))[uu]; } while (0)
#define SST(k) ((void)0)
#define SCAN_ITER(n, pre, Un, gl) do { const int u = u0 + (n) * NH; \
        _Pragma("unroll") for (int t = 0; t < 8; ++t) *(LAS u32x2*)(lds + SC_ST + dv * LD128B + 2 * (16 * t + 4 * fq)) = (u32x2){pk2(S[t][0], S[t][1]), pk2(S[t][2], S[t][3])}; \
        _Pragma("unroll") for (int k = 0; k < 5; ++k) { const int p = lane + 64 * k; if (p < 272) *(GAS u32x4*)(F.ws + WS_GH + (size_t)u * IMG_H + wave * 4352 + 16 * p) = *(const LAS u32x4*)(lds + SC_ST + wave * 4352 + 16 * p); } \
        SST(11); LBAR(); SST(12); \
        if ((n) + 1 < NCHUNK) WRITE_STAGE(pre, ((n) + 1) & 1); \
        SST(13); \
        if ((n) + 3 < NCHUNK) LOAD_STAGE(pre, u + 3 * NH); \
        _Pragma("unroll") for (int tc = 0; tc < 4; ++tc) U[tc] = (f32x4){bflo(Un[tc].x), bfhi(Un[tc].x), bflo(Un[tc].y), bfhi(Un[tc].y)}; \
        const float eg = __expf(gl); \
        if ((n) + 2 < NCHUNK) LOAD_U(Un, gl, u + 2 * NH); \
        const LAS uchar* st = lds + ((n) & 1) * SC_STG; SST(14); \
        gdn_step(st, st + IMG_W, lds + SC_ST, lds + SC_VNT, U, V, S, eg, wave, lane); SST(15); \
        _Pragma("unroll") for (int k = 0; k < 3; ++k) { const int p = lane + 64 * k; if (p < 144) *(GAS u32x4*)(F.ws + WS_GVNT + (size_t)u * IMG_VNT + wave * 2304 + 16 * p) = *(const LAS u32x4*)(lds + SC_VNT + wave * 2304 + 16 * p); } SST(16); \
    } while (0)
    const int u0 = (b * NCHUNK) * NH + h;
    LOAD_STAGE(preA, u0); WRITE_STAGE(preA, 0);
    LOAD_STAGE(preA, u0 + NH); LOAD_STAGE(preB, u0 + 2 * NH);
    LOAD_U(UnA, glA, u0); LOAD_U(UnB, glB, u0 + NH);
#pragma unroll 1
    for (int n = 0; n < NCHUNK; n += 2) { SCAN_ITER(n, preA, UnA, glA); SCAN_ITER(n + 1, preB, UnB, glB); }
#undef LOAD_STAGE
#undef WRITE_STAGE
#undef LOAD_U
#undef SCAN_ITER
    GAS float* s1 = F.out + O_GP + (size_t)((l * NPB + b) * NH + h) * HD * HD;
#pragma unroll
    for (int t = 0; t < 8; ++t)
#pragma unroll
        for (int reg = 0; reg < 4; ++reg) s1[(size_t)(16 * t + 4 * fq + reg) * HD + dv] = S[t][reg];
    LBAR();
}

constexpr int OP_Z = 81920, OP_O = 99328;
__device__ __forceinline__ void gdn_out_phase(Frame& F, int l) {
    LAS uchar* lds = F.lds; const int tid = F.tid, lane = F.lane, wave = F.wave, fr = lane & 15, fq = lane >> 4;
    constexpr int NP = (IMG_QD + IMG_ATT + IMG_VNT + IMG_H) / 16;
    u32x4 pre[10], prez[2];
    const GAS bf16_t* P = (const GAS bf16_t*)(F.ws + WS_P); GAS bf16_t* ob = (GAS bf16_t*)(F.ws + WS_OB);
#define OUT_LOAD(uu) do { _Pragma("unroll") for (int k_ = 0; k_ < 10; ++k_) { const int p_ = tid + 512 * k_; if (p_ < NP) { const int o_ = 16 * p_; \
        const GAS uchar* src_ = (o_ < OP_ATT) ? F.ws + WS_GQD + (size_t)(uu) * IMG_QD + o_ : (o_ < OP_VNT) ? F.ws + WS_GATT + (size_t)(uu) * IMG_ATT + (o_ - OP_ATT) : \
                            (o_ < OP_H) ? F.ws + WS_GVNT + (size_t)(uu) * IMG_VNT + (o_ - OP_VNT) : F.ws + WS_GH + (size_t)(uu) * IMG_H + (o_ - OP_H); \
        pre[k_] = *(const GAS u32x4*)src_; } } \
        { const int h_ = (uu) & 7, c_ = ((uu) >> 3) & 31, b_ = (uu) >> 8; const GAS bf16_t* zb_ = P + (size_t)(b_ * SEQ + c_ * 64) * NPROJ + CZ + h_ * HD; \
          _Pragma("unroll") for (int k_ = 0; k_ < 2; ++k_) { const int p_ = tid + 512 * k_; prez[k_] = *(const GAS u32x4*)(zb_ + (size_t)(p_ >> 4) * NPROJ + 8 * (p_ & 15)); } } } while (0)
    int u = F.vcu;
    if (u < NPU) OUT_LOAD(u);
    for (; u < NPU; u += F.G) {
#pragma unroll
        for (int k = 0; k < 10; ++k) { const int p = tid + 512 * k; if (p < NP) *(LAS u32x4*)(lds + 16 * p) = pre[k]; }
#pragma unroll
        for (int k = 0; k < 2; ++k) { const int p = tid + 512 * k; *(LAS u32x4*)(lds + OP_Z + (p >> 4) * LD128B + 16 * (p & 15)) = prez[k]; }
        LBAR();
        if (u + F.G < NPU) OUT_LOAD(u + F.G);
        const int h = u & 7, c = (u >> 3) & 31, b = u >> 8, row0 = b * SEQ + c * 64;
        const LAS uchar* pQD = lds + OP_QD; const LAS uchar* pATT = lds + OP_ATT; const LAS uchar* pH = lds + OP_H; const LAS uchar* pVNT = lds + OP_VNT; LAS float* red = (LAS float*)(lds + OP_RED);
        bf16x8 bH[4], bV[2], aQ[4][4], aA[4][2];
#pragma unroll
        for (int kk = 0; kk < 4; ++kk) bH[kk] = *(const LAS bf16x8*)(pH + (16 * wave + fr) * LD128B + kk * 64 + 16 * fq);
#pragma unroll
        for (int kk = 0; kk < 2; ++kk) bV[kk] = *(const LAS bf16x8*)(pVNT + (16 * wave + fr) * LD64B + kk * 64 + 16 * fq);
#pragma unroll
        for (int tc = 0; tc < 4; ++tc) {
#pragma unroll
            for (int kk = 0; kk < 4; ++kk) aQ[tc][kk] = *(const LAS bf16x8*)(pQD + (16 * tc + fr) * LD128B + kk * 64 + 16 * fq);
#pragma unroll
            for (int kk = 0; kk < 2; ++kk) aA[tc][kk] = *(const LAS bf16x8*)(pATT + (16 * tc + fr) * LD64B + kk * 64 + 16 * fq); }
        f32x4 O[4];
#pragma unroll
        for (int tc = 0; tc < 4; ++tc) O[tc] = (f32x4){0.f, 0.f, 0.f, 0.f};
#pragma unroll
        for (int kk = 0; kk < 4; ++kk)
#pragma unroll
            for (int tc = 0; tc < 4; ++tc) O[tc] = __builtin_amdgcn_mfma_f32_16x16x32_bf16(aQ[tc][kk], bH[kk], O[tc], 0, 0, 0);
#pragma unroll
        for (int kk = 0; kk < 2; ++kk)
#pragma unroll
            for (int tc = 0; tc < 4; ++tc) O[tc] = __builtin_amdgcn_mfma_f32_16x16x32_bf16(aA[tc][kk], bV[kk], O[tc], 0, 0, 0);
#pragma unroll
        for (int tc = 0; tc < 4; ++tc)
#pragma unroll
            for (int reg = 0; reg < 4; ++reg) { const float p = row_sum16(O[tc][reg] * O[tc][reg]); if (fr == 0) red[(16 * tc + 4 * fq + reg) * 8 + wave] = p; }
        LBAR();
        const int dv = 16 * wave + fr; const float nw = F.in[I_GNW][l * HD + dv];
#pragma unroll
        for (int tc = 0; tc < 4; ++tc)
#pragma unroll
            for (int reg = 0; reg < 4; ++reg) { const int cc = 16 * tc + 4 * fq + reg;
                const f32x4 r0 = *(const LAS f32x4*)(red + cc * 8), r1 = *(const LAS f32x4*)(red + cc * 8 + 4);
                const float tot = ((r0[0] + r0[1]) + (r0[2] + r0[3])) + ((r1[0] + r1[1]) + (r1[2] + r1[3]));
                const float z = bf1(*(const LAS bf16_t*)(lds + OP_Z + cc * LD128B + 2 * dv));
                const float v = O[tc][reg] * rsqrtf(tot * (1.f / HD) + NORM_EPS) * nw * siluf_(z);
                *(LAS bf16_t*)(lds + OP_O + cc * LD128B + 2 * dv) = (bf16_t)(pk2(v, 0.f) & 0xffffu); }
        LBAR();
#pragma unroll
        for (int k = 0; k < 2; ++k) { const int p = tid + 512 * k; *(GAS u32x4*)(ob + (size_t)(row0 + (p >> 4)) * DGDN + h * HD + 8 * (p & 15)) = *(const LAS u32x4*)(lds + OP_O + (p >> 4) * LD128B + 16 * (p & 15)); }
    }
    LBAR();
#undef OUT_LOAD
}

__device__ __forceinline__ void ln_load(Frame& F, int m, const GAS float* res_hi, f32x4 (&v)[8]) {
    const GAS float* X = (const GAS float*)(F.ws + WS_X); const GAS float* slab = (const GAS float*)(F.ws + WS_SLAB);
    if (m < MP) { const GAS float* xr = X + (size_t)m * DM;
#pragma unroll
        for (int j = 0; j < 8; ++j) v[j] = *(const GAS f32x4*)(xr + j * 256 + F.lane * 4);
    } else { const GAS float* xr = res_hi + (size_t)(m - MP) * DM;
#pragma unroll
        for (int j = 0; j < 8; ++j) v[j] = *(const GAS f32x4*)(xr + j * 256 + F.lane * 4) * alpha_();
#pragma unroll 2
        for (int p = 0; p < KPART; ++p) { const GAS float* sr = slab + ((size_t)p * MSR + (m - MP)) * DM;
#pragma unroll
            for (int j = 0; j < 8; ++j) v[j] += *(const GAS f32x4*)(sr + j * 256 + F.lane * 4); }
    }
}
__device__ __forceinline__ void ln_finish(Frame& F, int m, const GAS float* gam, const GAS float* bet, GAS float* dst, f32x4 (&v)[8], const int i8out) {
    GAS bf16_t* xb = (GAS bf16_t*)(F.ws + WS_XB); float s = 0.f;
#pragma unroll
    for (int j = 0; j < 8; ++j) s += (v[j][0] + v[j][1]) + (v[j][2] + v[j][3]);
    const float mean = wave_sum(s) * (1.f / DM); float s2 = 0.f;
#pragma unroll
    for (int j = 0; j < 8; ++j) { v[j] = v[j] - mean; s2 += (v[j][0] * v[j][0] + v[j][1] * v[j][1]) + (v[j][2] * v[j][2] + v[j][3] * v[j][3]); }
    const float rstd = rsqrtf(wave_sum(s2) * (1.f / DM) + LN_EPS);
    GAS float* orow = dst + (size_t)m * DM;
#pragma unroll
    for (int j = 0; j < 8; ++j) { const int k = j * 256 + F.lane * 4; const f32x4 g = *(const GAS f32x4*)(gam + k), bb = *(const GAS f32x4*)(bet + k);
        const f32x4 o = v[j] * rstd * g + bb; st_wt16f(orow + k, o);
        if (i8out == 1) *(GAS unsigned*)((GAS uchar*)xb + (size_t)m * DM + k) = pk4_i8(o[0] * pg8::XQ_SCALE, o[1] * pg8::XQ_SCALE, o[2] * pg8::XQ_SCALE, o[3] * pg8::XQ_SCALE);
        else { st_wt8(xb + (size_t)m * DM + k, (u32x2){pk2(o[0], o[1]), pk2(o[2], o[3])});
            if (i8out == 2) *(GAS unsigned*)(F.ws + WS_XB8 + (size_t)m * DM + k) = pk4_i8(o[0] * pg8::XQ_SCALE, o[1] * pg8::XQ_SCALE, o[2] * pg8::XQ_SCALE, o[3] * pg8::XQ_SCALE); } }
}
__device__ __forceinline__ void phase_ln(Frame& F, const GAS float* gam, const GAS float* bet, GAS float* dst, const GAS float* res_hi, const int i8out) {
    const int gw = F.vcu * 8 + F.wave, NGW = F.G * 8;
    const bool bal = (NGW == 2048);
    const int nrows = bal ? (gw < MSR ? 2 : 5) : (MT - gw + NGW - 1) / NGW;
#define LN_ROW(i) (bal ? (gw < MSR ? ((i) == 0 ? MP + gw : gw) : MSR + (gw - MSR) * 5 + (i)) : gw + (i) * NGW)
    f32x4 va[8], vb[8]; int i = 0;
    if (i < nrows) ln_load(F, LN_ROW(0), res_hi, va);
    while (i < nrows) {
        if (i + 1 < nrows) ln_load(F, LN_ROW(i + 1), res_hi, vb);
        ln_finish(F, LN_ROW(i), gam, bet, dst, va, i8out);
        if (i + 1 >= nrows) break;
        if (i + 2 < nrows) ln_load(F, LN_ROW(i + 2), res_hi, va);
        ln_finish(F, LN_ROW(i + 1), gam, bet, dst, vb, i8out);
        i += 2;
    }
#undef LN_ROW
}

constexpr int PH_PER_LAYER = 12, N_PHASES = DEPTH * PH_PER_LAYER;
__global__ void __launch_bounds__(512, 2) fwd_kernel(Args args) {
    extern __shared__ __attribute__((aligned(16))) uchar lds_raw[];
    Frame F;
    F.lds = (LAS uchar*)lds_raw;
    const int g_wave_ = __builtin_amdgcn_readfirstlane((int)threadIdx.x >> 6);
    F.tid = TID_NOW(g_wave_); F.lane = F.tid & 63; F.wave = g_wave_;
    F.G = gridDim.x; { const int bx = blockIdx.x; F.vcu = (F.G % 8 == 0) ? (bx % 8) * (F.G / 8) + bx / 8 : bx; }
    F.in = (const GAS float* const*)args.in; F.out = (GAS float*)args.out; F.ws = (GAS uchar*)args.ws;
    volatile LAS unsigned* MISC = (volatile LAS unsigned*)(F.lds + MISC_OFF);
    if (F.tid < 64) MISC[F.tid] = 0u;
    __syncthreads();
    const bool multi = (args.ph_hi - args.ph_lo) > 1;
    XcdBarrier bar; bar.bar = (unsigned*)(F.ws + WS_CTL) + 4096; bar.x = 0; bar.st = nullptr;
    if (multi) bar = xcd_barrier_post((unsigned*)(F.ws + WS_CTL) + 4096, MISC + 8, g_wave_);
    const int lo = args.ph_lo, hi = args.ph_hi;
#pragma unroll 1
    for (int ph = lo; ph < hi; ++ph) {
        const int l = ph / PH_PER_LAYER, k = ph % PH_PER_LAYER;
#define PHASE_IDS() do { const int t_ = TID_NOW(g_wave_); F.tid = t_; F.lane = t_ & 63; F.wave = g_wave_; } while (0)
        { int g_ = (int)gridDim.x; asm volatile("" : "+s"(g_)); F.G = g_;
          GAS uchar* w_ = (GAS uchar*)args.ws; asm volatile("" : "+s"(w_)); F.ws = w_;
          GAS float* o_ = (GAS float*)args.out; asm volatile("" : "+s"(o_)); F.out = o_; }
        const GAS bf16_t* WIN = (const GAS bf16_t*)(F.ws + WS_WIN); const GAS bf16_t* WA = (const GAS bf16_t*)(F.ws + WS_WA); const GAS bf16_t* WB = (const GAS bf16_t*)(F.ws + WS_WB);
        const GAS bf16_t* WO = (const GAS bf16_t*)(F.ws + WS_WO); const GAS bf16_t* WUP = (const GAS bf16_t*)(F.ws + WS_WUP); const GAS bf16_t* WD = (const GAS bf16_t*)(F.ws + WS_WD);
        GAS bf16_t* P = (GAS bf16_t*)(F.ws + WS_P); GAS bf16_t* XB = (GAS bf16_t*)(F.ws + WS_XB); GAS float* X = (GAS float*)(F.ws + WS_X);
        GAS bf16_t* AIN = (GAS bf16_t*)(F.ws + WS_AIN); GAS bf16_t* OB = (GAS bf16_t*)(F.ws + WS_OB); GAS bf16_t* MG = (GAS bf16_t*)(F.ws + WS_MG); GAS bf16_t* T1 = (GAS bf16_t*)(F.ws + WS_T1); GAS bf16_t* HID = P;
        switch (k) {
        case 0: PHASE_IDS(); phase_conv(F, l); break;
        case 1: {
                  { pg8::Gemm g{XB, (const GAS bf16_t*)(F.ws + WS_WIN8), MT, NPROJ, DM / 2}; g.A = (const GAS bf16_t*)(F.ws + WS_XB8);
                    pg8::MixOrder S; S.init(0, DM / 2, F.G, F.vcu, (int)blockIdx.x); pg8::EpiStoreBf16<true> E{P, NPROJ, 1.f / (pg8::XQ_SCALE * pg8::WIN_SCALE)};
                    pg8::gemm_phase<pg8::EpiStoreBf16<true>, pg8::MixOrder, true, true, 2>(F.lds, g, S, E, g_wave_); }
                  { pg8::Gemm g{XB, WIN, MT, NPROJ, DM}; pg8::MixOrder S; S.init(1, DM, F.G, F.vcu, (int)blockIdx.x); pg8::EpiStoreBf16<false> E{P, NPROJ, 1.f};
                    pg8::gemm_phase<pg8::EpiStoreBf16<false>, pg8::MixOrder, true, true, 0>(F.lds, g, S, E, g_wave_); }
                  PHASE_IDS(); phase_logits(F, l); } break;
        case 2: { PHASE_IDS();
                  for (int u = F.vcu; u < NPU; u += F.G) gdn_prompt_prepare_unit(F, l, u);
                  for (int u = F.vcu; u < 384; u += F.G) mixa_unit(F, l, u); } break;
        case 3: { PHASE_IDS();
                  {
                      if ((int)blockIdx.x < NPB * NH) gdn_scan_unit(F, l, (int)blockIdx.x);
                      else { pg8::Gemm g{AIN, WA, MT, DM, DCONV}; pg8::StaticOrder S; S.init(MT, DM, DCONV, F.G - NPB * NH, (int)blockIdx.x - NPB * NH); pg8::EpiGate<false, false> E{P, NPROJ, CMA, nullptr, T1, DM, 1.f};
                             pg8::gemm_phase<pg8::EpiGate<false, false>, pg8::StaticOrder, true, true, 0>(F.lds, g, S, E, g_wave_); }
                  } } break;
        case 4: PHASE_IDS(); for (int base = F.vcu * 4; base < NSB * NH; base += F.G * 4) gdn_sample_wave(F, l, base);
                gdn_out_phase(F, l); break;
        case 5:
            break;
        case 6: { pg8::Gemm g{OB, WB, MT, DM, DGDN}; pg8::StaticOrder S; S.init(MT, DM, DGDN, F.G, (int)blockIdx.x); pg8::EpiGate<true, false> E{P, NPROJ, CMB, T1, MG, DM, 1.f};
                  pg8::gemm_phase<pg8::EpiGate<true, false>, pg8::StaticOrder, true, true, 0>(F.lds, g, S, E, g_wave_); } break;
        case 7: { pg8::Gemm g{MG, WO, MT, DM, DM / 2}; pg8::SplitOrder S; S.init(DM / 2, KPART, F.G, (int)blockIdx.x);
                  pg8::EpiResSplit<true> E{l == 0 ? F.in[I_XP] : X, X, DM, (GAS float*)(F.ws + WS_SLAB), MP, MSR, 1.f / (pg8::MG_SCALE * pg8::WO_SCALE)};
                  pg8::gemm_phase<pg8::EpiResSplit<true>, pg8::SplitOrder, true, true, 2>(F.lds, g, S, E, g_wave_); } break;
        case 8: PHASE_IDS(); phase_ln(F, F.in[I_L1G] + (size_t)l * DM, F.in[I_L1B] + (size_t)l * DM, X, l == 0 ? F.in[I_XS] : X + (size_t)MP * DM, 1); break;
        case 9: {
                  pg8::Gemm g{XB, WUP, MT, DFF, DM / 2}; pg8::StaticOrder S; S.init(MT, DFF, DM / 2, F.G, (int)blockIdx.x); pg8::EpiRelu2 E{(GAS uchar*)HID, DFF, 1.f / (pg8::XQ_SCALE * pg8::WUP_SCALE)};
                  pg8::gemm_phase<pg8::EpiRelu2, pg8::StaticOrder, true, true, 2>(F.lds, g, S, E, g_wave_); } break;
        case 10: {
                  pg8::Gemm g{HID, WD, MT, DM, DFF / 2}; pg8::SplitOrder S; S.init(DFF / 2, KPART, F.G, (int)blockIdx.x);
                  pg8::EpiResSplit<true> E{X, X, DM, (GAS float*)(F.ws + WS_SLAB), MP, MSR, 1.f / (pg8::HID_SCALE * pg8::WD_SCALE)};
                  pg8::gemm_phase<pg8::EpiResSplit<true>, pg8::SplitOrder, true, true, 2>(F.lds, g, S, E, g_wave_); } break;
        case 11: PHASE_IDS(); phase_ln(F, F.in[I_L2G] + (size_t)l * DM, F.in[I_L2B] + (size_t)l * DM, l == DEPTH - 1 ? F.out + O_YP : X, X + (size_t)MP * DM, l == DEPTH - 1 ? 0 : 2); break;
        }
        if (ph + 1 < hi && k != 5) xcd_barrier(bar, g_wave_);
    }
}

extern "C" void kernel_launch(void* const* d_in, const int* in_sizes, int n_in, void* d_out, int out_size, void* d_ws, size_t ws_size, hipStream_t stream) {
    static int grid = 0;
    if (grid == 0) {
        if (n_in != 20 || (size_t)out_size != O_END || ws_size < WS_END) { fprintf(stderr, "kernel_launch: unexpected problem: n_in %d out %d ws %zu (need %zu)\n", n_in, out_size, ws_size, (size_t)WS_END); grid = -1; return; }
        int dev = 0, cus = 0, per_cu = 0;
        hipGetDevice(&dev); hipDeviceGetAttribute(&cus, hipDeviceAttributeMultiprocessorCount, dev);
        if (hipFuncSetAttribute((const void*)fwd_kernel, hipFuncAttributeMaxDynamicSharedMemorySize, LDS_BYTES) != hipSuccess) { fprintf(stderr, "kernel_launch: hipFuncSetAttribute failed\n"); grid = -1; return; }
        if (hipOccupancyMaxActiveBlocksPerMultiprocessor(&per_cu, (const void*)fwd_kernel, 512, LDS_BYTES) != hipSuccess || per_cu < 1) { fprintf(stderr, "kernel_launch: occupancy query says %d\n", per_cu); per_cu = 1; }
        (void)hipGetLastError();
        grid = cus;
        if (grid < 64) { fprintf(stderr, "kernel_launch: needs at least 64 CUs\n"); grid = -1; return; }
    }
    if (grid < 0) return;
    hipMemsetAsync((char*)d_ws + WS_CTL, 0, CTL_ZERO_BYTES, stream);
    Args a{};
    for (int i = 0; i < 20; ++i) a.in[i] = (const float*)d_in[i];
    a.out = (float*)d_out; a.ws = (uchar*)d_ws;
#ifndef MK_ONE_LAUNCH
#define MK_ONE_LAUNCH 1
#endif
#if MK_ONE_LAUNCH
    a.ph_lo = 0; a.ph_hi = N_PHASES;
    void* kargs[] = {&a};
    hipError_t e = hipLaunchCooperativeKernel((const void*)fwd_kernel, dim3(grid), dim3(512), kargs, LDS_BYTES, stream);
    if (e != hipSuccess) fprintf(stderr, "kernel_launch: cooperative launch failed: %s\n", hipGetErrorString(e));
#else
    for (int ph = 0; ph < N_PHASES; ++ph) {
        a.ph_lo = ph; a.ph_hi = ph + 1;
        hipLaunchKernelGGL(fwd_kernel, dim3(grid), dim3(512), LDS_BYTES, stream, a);
    }
#endif
}
```

```cpp
#include <hip/hip_runtime.h>
#include <cstdio>
#include <cstdint>

#define LAS __attribute__((address_space(3)))
#define GAS __attribute__((address_space(1)))
typedef unsigned short bf16_t;
typedef short bf16x8 __attribute__((ext_vector_type(8)));
typedef float f32x4 __attribute__((ext_vector_type(4)));
typedef float f32x2 __attribute__((ext_vector_type(2)));
typedef unsigned u32x4 __attribute__((ext_vector_type(4)));
typedef unsigned u32x2 __attribute__((ext_vector_type(2)));
typedef __bf16 bf16x2_t __attribute__((ext_vector_type(2)));
typedef unsigned char uchar;
typedef int i32x8 __attribute__((ext_vector_type(8)));
typedef int i32x4 __attribute__((ext_vector_type(4)));

constexpr int DM = 2048, NPB = 4, SEQ = 2048, NSB = 128, SSEQ = 4, DEPTH = 2;
constexpr int MP = NPB * SEQ, MSR = NSB * SSEQ, MT = MP + MSR;
constexpr int DCONV = 1024, DGDN = 1024, NH = 8, HD = 128, DFF = 8192;
constexpr int NPROJ_REF = 11280, NPROJ = 11264;
constexpr int CB = 0, CC = 1024, CHH = 2048, CQ = 3072, CK = 4096, CV = 5120, CZ = 6144, CMA = 7168, CMB = 9216;
constexpr float ALPHA = 1.41421356237309515f;
constexpr float LN_EPS = 1e-5f, NORM_EPS = 1e-6f;
#ifndef FP8_SP2
#define FP8_SP2 false
#endif
constexpr int KPART = 8;
constexpr int NCHUNK = SEQ / 64;
constexpr int NPU = NPB * NCHUNK * NH;

constexpr size_t O_YP = 0, O_YS = 16777216, O_CAP = 17825792, O_GCP = 17842176, O_GP = 17915904, O_CAS = 18964480, O_GCS = 19488768, O_GS = 21848064, O_END = 55402496;

constexpr size_t MiB = 1u << 20;
constexpr size_t WS_CTL = 0, CTL_ZERO_BYTES = 1 * MiB;
constexpr size_t WS_WIN = 1 * MiB, WS_WA = 45 * MiB, WS_WB = 49 * MiB, WS_WO = 53 * MiB, WS_WUP = 61 * MiB, WS_WD = 93 * MiB;
constexpr size_t WS_WLG = 125 * MiB, WS_LG = 126 * MiB, WS_GL = 127 * MiB;
constexpr size_t WS_P = 128 * MiB;
constexpr size_t WS_XB = 315 * MiB;
constexpr size_t WS_X = 349 * MiB;
constexpr size_t WS_AIN = 417 * MiB, WS_OB = 434 * MiB, WS_MG = 451 * MiB;
constexpr size_t WS_GDN = 485 * MiB;
constexpr int IMG_W = 17408, IMG_KDT = 18432, IMG_QD = 17408, IMG_ATT = 9216, IMG_UT = 18432, IMG_VNT = 18432, IMG_H = 34816;
constexpr size_t WS_GW = WS_GDN, WS_GKDT = WS_GW + (size_t)NPU * IMG_W, WS_GQD = WS_GKDT + (size_t)NPU * IMG_KDT, WS_GATT = WS_GQD + (size_t)NPU * IMG_QD,
                 WS_GUT = WS_GATT + (size_t)NPU * IMG_ATT, WS_GVNT = WS_GUT + (size_t)NPU * IMG_UT, WS_GH = WS_GVNT + (size_t)NPU * IMG_VNT, WS_GDN_END = WS_GH + (size_t)NPU * IMG_H;
constexpr size_t WS_SLAB = WS_GDN;
constexpr size_t WS_T1 = 616 * MiB;
constexpr size_t WS_XB8 = 650 * MiB;
constexpr size_t WS_WIN8 = 667 * MiB;
constexpr size_t WS_END = 689 * MiB;
static_assert(WS_GDN_END <= WS_T1, "ws map");

__device__ __forceinline__ int lane_now() { int l; asm volatile("v_mbcnt_lo_u32_b32 %0, -1, 0\n\tv_mbcnt_hi_u32_b32 %0, -1, %0" : "=v"(l)); return l; }
#define TID_NOW(wave_s) (((wave_s) << 6) | lane_now())
#if defined(__HIP_DEVICE_COMPILE__)
#define ASSUME_GLOBAL(p) __builtin_assume(!__builtin_amdgcn_is_shared((const void*)(p)) && !__builtin_amdgcn_is_private((const void*)(p)))
#else
#define ASSUME_GLOBAL(p) ((void)0)
#endif
__device__ __forceinline__ unsigned pk2(float lo, float hi) { f32x2 v = {lo, hi}; bf16x2_t b = __builtin_convertvector(v, bf16x2_t); return __builtin_bit_cast(unsigned, b); }
__device__ __forceinline__ i32x8 cat8(bf16x8 lo, bf16x8 hi) { const i32x4 a = __builtin_bit_cast(i32x4, lo), b = __builtin_bit_cast(i32x4, hi); return (i32x8){a[0], a[1], a[2], a[3], b[0], b[1], b[2], b[3]}; }
__device__ __forceinline__ unsigned pk4_fp8(float a, float b, float c, float d) { unsigned w = __builtin_amdgcn_cvt_pk_fp8_f32(a, b, 0u, false); return __builtin_amdgcn_cvt_pk_fp8_f32(c, d, w, true); }
__device__ __forceinline__ unsigned pk4_i8(float a, float b, float c, float d) {
    unsigned w = __builtin_amdgcn_cvt_pk_u8_f32(__builtin_rintf(a) + 128.f, 0, 0u); w = __builtin_amdgcn_cvt_pk_u8_f32(__builtin_rintf(b) + 128.f, 1, w);
    w = __builtin_amdgcn_cvt_pk_u8_f32(__builtin_rintf(c) + 128.f, 2, w); w = __builtin_amdgcn_cvt_pk_u8_f32(__builtin_rintf(d) + 128.f, 3, w); return w ^ 0x80808080u; }
__device__ __forceinline__ float bflo(unsigned w) { return __uint_as_float(w << 16); }
__device__ __forceinline__ float bfhi(unsigned w) { return __uint_as_float(w & 0xffff0000u); }
__device__ __forceinline__ float bf1(bf16_t b) { return __uint_as_float((unsigned)b << 16); }
__device__ __forceinline__ float alpha_() { float a = ALPHA; asm volatile("" : "+s"(a)); return a; }
__device__ __forceinline__ float softplusf_(float x) { return x > 15.f ? x : __logf(1.f + __expf(x)); }
__device__ __forceinline__ float sigmoidf_(float x) { return __builtin_amdgcn_rcpf(1.f + __expf(-x)); }
__device__ __forceinline__ float siluf_(float x) { return x * __builtin_amdgcn_rcpf(1.f + __expf(-x)); }
__device__ __forceinline__ float row_sum16(float v) {
    v += __builtin_bit_cast(float, __builtin_amdgcn_update_dpp(0, __builtin_bit_cast(int, v), 0xB1, 0xF, 0xF, true));
    v += __builtin_bit_cast(float, __builtin_amdgcn_update_dpp(0, __builtin_bit_cast(int, v), 0x4E, 0xF, 0xF, true));
    v += __builtin_bit_cast(float, __builtin_amdgcn_update_dpp(0, __builtin_bit_cast(int, v), 0x141, 0xF, 0xF, true));
    v += __builtin_bit_cast(float, __builtin_amdgcn_update_dpp(0, __builtin_bit_cast(int, v), 0x140, 0xF, 0xF, true));
    return v;
}
__device__ __forceinline__ float wave_sum(float v) {
    v = row_sum16(v);
    const int iv = __builtin_bit_cast(int, v);
    const float a = __builtin_bit_cast(float, __builtin_amdgcn_readlane(iv, 0)), b = __builtin_bit_cast(float, __builtin_amdgcn_readlane(iv, 16)),
                c = __builtin_bit_cast(float, __builtin_amdgcn_readlane(iv, 32)), d = __builtin_bit_cast(float, __builtin_amdgcn_readlane(iv, 48));
    return (a + b) + (c + d);
}
__device__ __forceinline__ void fmac1(float& d, float a, float b) { asm("v_fmac_f32_e32 %0, %1, %2" : "+v"(d) : "v"(a), "v"(b)); }
__device__ __forceinline__ void st_wt16(GAS void* p, u32x4 v) { asm volatile("global_store_dwordx4 %0, %1, off sc1\n\ts_nop 1" :: "v"(p), "v"(v) : "memory"); }
__device__ __forceinline__ void st_wt16f(GAS void* p, f32x4 v) { asm volatile("global_store_dwordx4 %0, %1, off sc1\n\ts_nop 1" :: "v"(p), "v"(v) : "memory"); }
__device__ __forceinline__ void st_wt8(GAS void* p, u32x2 v) { asm volatile("global_store_dwordx2 %0, %1, off sc1\n\ts_nop 0" :: "v"(p), "v"(v) : "memory"); }
#define LDS_WAIT() asm volatile("s_waitcnt lgkmcnt(0)" ::: "memory")
#define LBAR() do { asm volatile("s_waitcnt lgkmcnt(0)" ::: "memory"); __builtin_amdgcn_s_barrier(); asm volatile("" ::: "memory"); } while (0)
#define VM_WAIT() asm volatile("s_waitcnt vmcnt(0)" ::: "memory")

namespace pg8 {
constexpr int BM = 256, BK = 64, HALF = 128, HTB = HALF * BK * 2, STAGE_BYTES = 8 * HTB, NXCD = 8, WGM = 8;
__host__ __device__ __forceinline__ int lds_byte(int r, int c) { const int st = (r >> 4) * 2 + (c >> 5), rr = r & 15, cc = c & 31, ob = rr * 64 + cc * 2; return st * 1024 + (ob ^ (((ob >> 9) & 1) << 5)); }
__host__ __device__ __forceinline__ void stage_rc(int b, int& R, int& C) { const int st = b / 1024, sb = b % 1024, swz = sb ^ (((sb >> 9) & 1) << 5); R = (st >> 1) * 16 + swz / 64; C = (st & 1) * 32 + (swz % 64) / 2; }
__host__ __device__ __forceinline__ int perm32(int rho) { const int n = rho >> 4, i = rho & 15; return 8 * (i >> 2) + 4 * n + (i & 3); }

struct Unit { int pm, pn, k0, nt, part; };
struct Gemm { const GAS bf16_t* A; const GAS bf16_t* Bt; int M, N, K; };

struct StaticOrder {
    int nM, nN, nwg, G, c;
    int ntK;
    __device__ __forceinline__ void init(int M, int N, int K, int G_, int c_) { nM = M / BM; nN = N / BM; nwg = nM * nN; G = G_; c = c_; ntK = K / BK; }
    __device__ __forceinline__ bool next(int i, Unit& u) const {
        const long L = (long)i * G + c; if (L >= nwg || c < 0) return false;
        u.k0 = 0; u.nt = ntK; u.part = -1;
        int wgid = (int)L; { const int q = nwg / NXCD, r = nwg % NXCD, xcd = wgid % NXCD, off = wgid / NXCD; wgid = (xcd < r ? xcd * (q + 1) : r * (q + 1) + (xcd - r) * q) + off; }
        const int nig = WGM * nN, gid = wgid / nig, fm = gid * WGM, gsz = (nM - fm) < WGM ? (nM - fm) : WGM;
        u.pm = fm + ((wgid % nig) % gsz); u.pn = (wgid % nig) / gsz; return true;
    }
    __device__ __forceinline__ void a_ready(const Unit&) const {}
    __device__ __forceinline__ void done(const Unit&) const {}
};

struct SplitOrder {
    int G, c, KP, ntK;
    __device__ __forceinline__ void init(int K, int KP_, int G_, int c_) { G = G_; c = c_; KP = KP_; ntK = K / BK; }
    __device__ __forceinline__ bool next(int i, Unit& u) const {
        const int L = i * G + c; const bool whole = L < 256; const int L2 = L - 256;
        const int x = L & 7, j = L >> 3, tile = L2 / KP, part = L2 - tile * KP, ntp = ntK / KP;
        u.pm = whole ? 4 * x + (j >> 3) : 32 + (tile >> 3); u.pn = whole ? (j & 7) : (tile & 7);
        u.k0 = whole ? 0 : part * ntp; u.nt = whole ? ntK : ntp; u.part = whole ? -1 : part;
        return L2 < 16 * KP;
    }
    __device__ __forceinline__ void a_ready(const Unit&) const {}
    __device__ __forceinline__ void done(const Unit&) const {}
};

struct MixOrder {
    int G, v, cls, ntK, first, count;
    __device__ __forceinline__ void init(int cls_, int K, int G_, int vcu, int c) { G = G_; cls = cls_; ntK = K / BK; v = vcu;
        if (G == 256) {
            if (cls == 1) { if (v < 88) { first = 2 * v; count = 2; } else { first = 176 + (v - 88); count = 1; } }
            else { if (v < 48) { first = 4 * v; count = 4; } else if (v < 88) { first = 192 + 3 * (v - 48); count = 3; } else { first = 312 + 5 * (v - 88); count = 5; } }
        } else { const int n = cls == 1 ? 344 : 1152; first = c; count = (n - c + G - 1) / G; if (count < 0) count = 0; }
    }
    __device__ __forceinline__ bool next(int i, Unit& u) const {
        const int idx = (G == 256) ? first + i : first + i * G;
        int pm, pn;
        if (cls == 1) { const bool nrm = idx < 224; const int j = nrm ? idx : idx - 224; const int n = j >> 3, sp = j / 20, t = j - sp * 20;
            pm = nrm ? n + n / 7 : (sp < 4 ? 8 * sp + 7 : 28 + sp); pn = nrm ? 16 + (j & 7) : 4 + t; }
        else { const bool nrm = idx < 1008; const int j = nrm ? idx : idx - 1008; const int n = j / 36, t = j - n * 36, sp = j / 24, t2 = j - sp * 24;
            pm = nrm ? n + n / 7 : (sp < 4 ? 8 * sp + 7 : 28 + sp); pn = nrm ? (t < 16 ? t : t + 8) : (t2 < 4 ? t2 : t2 + 20); }
        u.pm = pm; u.pn = pn; u.k0 = 0; u.nt = ntK; u.part = -1;
        return i < count;
    }
    __device__ __forceinline__ void a_ready(const Unit&) const {}
    __device__ __forceinline__ void done(const Unit&) const {}
};

struct D1Order {
    int c, ntK;
    __device__ __forceinline__ void init(int K, int c_) { c = c_; ntK = K / BK; }
    __device__ __forceinline__ bool next(int i, Unit& u) const {
        const bool smp = c >= 208; const int t = c - 208, p = (i == 0) ? c : 208 + c, x = p & 7, j = p >> 3;
        u.pm = smp ? 32 + (t >> 3) : 4 * x + (j >> 3); u.pn = smp ? (t & 7) : (j & 7); u.k0 = 0; u.nt = ntK; u.part = -1;
        return c >= 0 && (i == 0 || (i == 1 && c < 48));
    }
    __device__ __forceinline__ void a_ready(const Unit&) const {}
    __device__ __forceinline__ void done(const Unit&) const {}
};
struct ListOrder {
    int first, count, ntK;
    __device__ __forceinline__ void init(int K, int first_, int count_) { first = first_; count = count_; ntK = K / BK; }
    __device__ __forceinline__ bool next(int i, Unit& u) const {
        const int p = first + i; const bool smp = p >= 256; const int t = p - 256, x = p & 7, j = p >> 3;
        u.pm = smp ? 32 + (t >> 3) : 4 * x + (j >> 3); u.pn = smp ? (t & 7) : (j & 7); u.k0 = 0; u.nt = ntK; u.part = -1;
        return i < count;
    }
    __device__ __forceinline__ void a_ready(const Unit&) const {}
    __device__ __forceinline__ void done(const Unit&) const {}
};

template <bool IACC> struct EpiStoreBf16 {
    static constexpr bool PERM = true;
    GAS bf16_t* O; int ldc; float ascale;
    __device__ __forceinline__ void operator()(const f32x4 (&acc)[2][2][4][2], const Unit& u, int wr, int wc, int fr, int fq) const {
        const int row0 = u.pm * BM + wr * 64 + fr, col0 = u.pn * BM + wc * 32 + 8 * fq;
#pragma unroll
        for (int ai = 0; ai < 2; ++ai)
#pragma unroll
            for (int m = 0; m < 4; ++m) { GAS bf16_t* rowp = O + (size_t)(row0 + ai * HALF + m * 16) * ldc + col0;
#pragma unroll
                for (int bj = 0; bj < 2; ++bj) { f32x4 v0, v1;
                    if constexpr (IACC) { const i32x4 i0 = __builtin_bit_cast(i32x4, acc[ai][bj][m][0]), i1 = __builtin_bit_cast(i32x4, acc[ai][bj][m][1]);
#pragma unroll
                        for (int e = 0; e < 4; ++e) { v0[e] = (float)i0[e] * ascale; v1[e] = (float)i1[e] * ascale; } }
                    else { v0 = acc[ai][bj][m][0]; v1 = acc[ai][bj][m][1]; }
                    u32x4 w; w.x = pk2(v0[0], v0[1]); w.y = pk2(v0[2], v0[3]); w.z = pk2(v1[0], v1[1]); w.w = pk2(v1[2], v1[3]);
                    *(GAS u32x4*)(rowp + bj * HALF) = w; } }
    }
};
constexpr float HID_SCALE = 20.f, WD_SCALE = 4096.f;
constexpr float XQ_SCALE = 16.f, WUP_SCALE = 2048.f, WIN_SCALE = 1024.f;
constexpr float AIN_SCALE = 24.f, OB_SCALE = 16.f, WAB_SCALE = 1024.f, MG_SCALE = 64.f, WO_SCALE = 2048.f;
struct EpiRelu2 {
    static constexpr bool PERM = true;
    GAS uchar* O; int ldc; float ascale;
    __device__ __forceinline__ void operator()(const f32x4 (&acc)[2][2][4][2], const Unit& u, int wr, int wc, int fr, int fq) const {
        const int row0 = u.pm * BM + wr * 64 + fr, col0 = u.pn * BM + wc * 32 + 8 * fq;
#pragma unroll
        for (int ai = 0; ai < 2; ++ai)
#pragma unroll
            for (int m = 0; m < 4; ++m) { GAS uchar* rowp = O + (size_t)(row0 + ai * HALF + m * 16) * ldc + col0;
#pragma unroll
                for (int bj = 0; bj < 2; ++bj) { const i32x4 i0 = __builtin_bit_cast(i32x4, acc[ai][bj][m][0]), i1 = __builtin_bit_cast(i32x4, acc[ai][bj][m][1]); f32x4 v0, v1;
#pragma unroll
                    for (int e = 0; e < 4; ++e) { const float a = fmaxf((float)i0[e] * ascale, 0.f), b = fmaxf((float)i1[e] * ascale, 0.f); v0[e] = a * a * HID_SCALE; v1[e] = b * b * HID_SCALE; }
                    *(GAS u32x2*)(rowp + bj * HALF) = (u32x2){pk4_i8(v0[0], v0[1], v0[2], v0[3]), pk4_i8(v1[0], v1[1], v1[2], v1[3])}; } }
    }
};
template <bool ADD, bool IACC> struct EpiGate {
    static constexpr bool PERM = true;
    const GAS bf16_t* P; int ldp, gcol; const GAS bf16_t* T1in; GAS bf16_t* O; int ldc; float ascale;
    __device__ __forceinline__ void operator()(const f32x4 (&acc)[2][2][4][2], const Unit& u, int wr, int wc, int fr, int fq) const {
        const int row0 = u.pm * BM + wr * 64 + fr, col0 = u.pn * BM + wc * 32 + 8 * fq;
#pragma unroll
        for (int ai = 0; ai < 2; ++ai)
#pragma unroll
            for (int m = 0; m < 4; ++m) { const size_t row = (size_t)(row0 + ai * HALF + m * 16);
#pragma unroll
                for (int bj = 0; bj < 2; ++bj) {
                    const u32x4 gv = *(const GAS u32x4*)(P + row * ldp + gcol + col0 + bj * HALF);
                    f32x4 v0, v1;
                    if constexpr (IACC) { const i32x4 i0 = __builtin_bit_cast(i32x4, acc[ai][bj][m][0]), i1 = __builtin_bit_cast(i32x4, acc[ai][bj][m][1]);
#pragma unroll
                        for (int e = 0; e < 4; ++e) { v0[e] = (float)i0[e] * ascale; v1[e] = (float)i1[e] * ascale; } }
                    else { v0 = acc[ai][bj][m][0]; v1 = acc[ai][bj][m][1]; }
                    v0[0] *= sigmoidf_(bflo(gv.x)); v0[1] *= sigmoidf_(bfhi(gv.x)); v0[2] *= sigmoidf_(bflo(gv.y)); v0[3] *= sigmoidf_(bfhi(gv.y));
                    v1[0] *= sigmoidf_(bflo(gv.z)); v1[1] *= sigmoidf_(bfhi(gv.z)); v1[2] *= sigmoidf_(bflo(gv.w)); v1[3] *= sigmoidf_(bfhi(gv.w));
                    if constexpr (ADD) { const u32x4 tv = *(const GAS u32x4*)(T1in + row * ldc + col0 + bj * HALF);
                        v0[0] += bflo(tv.x); v0[1] += bfhi(tv.x); v0[2] += bflo(tv.y); v0[3] += bfhi(tv.y);
                        v1[0] += bflo(tv.z); v1[1] += bfhi(tv.z); v1[2] += bflo(tv.w); v1[3] += bfhi(tv.w);
                        v0 = v0 * MG_SCALE; v1 = v1 * MG_SCALE;
                        *(GAS u32x2*)((GAS uchar*)O + row * ldc + col0 + bj * HALF) = (u32x2){pk4_i8(v0[0], v0[1], v0[2], v0[3]), pk4_i8(v1[0], v1[1], v1[2], v1[3])};
                    } else {
                    u32x4 w; w.x = pk2(v0[0], v0[1]); w.y = pk2(v0[2], v0[3]); w.z = pk2(v1[0], v1[1]); w.w = pk2(v1[2], v1[3]);
                    *(GAS u32x4*)(O + row * ldc + col0 + bj * HALF) = w; } }
                asm volatile("" ::: "memory"); }
    }
};
template <bool IACC> struct EpiResSplit {
    static constexpr bool PERM = false;
    __device__ __forceinline__ static f32x4 cvt(const f32x4& a) { if constexpr (IACC) { const i32x4 i = __builtin_bit_cast(i32x4, a); return (f32x4){(float)i[0], (float)i[1], (float)i[2], (float)i[3]}; } else return a; }
    const GAS float* res; GAS float* out; int ldc; GAS float* slab; int split, nrows_hi; float scale;
    __device__ __forceinline__ void operator()(const f32x4 (&acc)[2][2][4][2], const Unit& u, int wr, int wc, int fr, int fq) const {
        const int row0 = u.pm * BM + wr * 64 + fr, col0 = u.pn * BM + wc * 32 + 4 * fq;
        if (u.part < 0) {
#pragma unroll
            for (int ai = 0; ai < 2; ++ai)
#pragma unroll
                for (int m = 0; m < 4; ++m) { const int r = row0 + ai * HALF + m * 16; const GAS float* rp = res + (size_t)r * ldc + col0; GAS float* op = out + (size_t)r * ldc + col0;
#pragma unroll
                    for (int bj = 0; bj < 2; ++bj)
#pragma unroll
                        for (int n = 0; n < 2; ++n) { const f32x4 bs = *(const GAS f32x4*)(rp + bj * HALF + n * 16); *(GAS f32x4*)(op + bj * HALF + n * 16) = bs * alpha_() + cvt(acc[ai][bj][m][n]) * scale; }
                    if (m & 1) asm volatile("" ::: "memory"); }
        } else {
            GAS float* sb = slab + (size_t)u.part * nrows_hi * ldc;
#pragma unroll
            for (int ai = 0; ai < 2; ++ai)
#pragma unroll
                for (int m = 0; m < 4; ++m) { const int r = row0 + ai * HALF + m * 16 - split; GAS float* op = sb + (size_t)r * ldc + col0;
#pragma unroll
                    for (int bj = 0; bj < 2; ++bj)
#pragma unroll
                        for (int n = 0; n < 2; ++n) *(GAS f32x4*)(op + bj * HALF + n * 16) = cvt(acc[ai][bj][m][n]) * scale; }
        }
    }
};

template <class Epi, class Sched, bool ALIGN_EPI, bool SP2, int MODE = 0>
__device__ __forceinline__ void gemm_phase(LAS uchar* lds, const Gemm g, const Sched& S, const Epi& E, const int wave_s) {
    int tid_ = TID_NOW(wave_s);
    const int tid = tid_, wid = __builtin_amdgcn_readfirstlane(tid >> 6), lane = tid & 63, wr = wid >> 2, wc = wid & 3, fr = lane & 15, fq = lane >> 4;
    constexpr bool FP8 = (MODE == 1);
    const int K = g.K;
    unsigned voffA[2], voffB_[2];
#pragma unroll
    for (int i = 0; i < 2; ++i) { int R, C; stage_rc(tid * 16 + i * 8192, R, C); const int Rb = Epi::PERM ? ((R & ~31) + perm32(R & 31)) : R;
        voffA[i] = (unsigned)(R * K + C) * 2u; voffB_[i] = (unsigned)(Rb * K + C) * 2u; }
    unsigned (&voffB)[2] = Epi::PERM ? voffB_ : voffA;
    const size_t kstep = (size_t)(BK * 2);
    const size_t hstep = (size_t)HALF * K * 2;
    const size_t tstep = 2 * hstep;
    const unsigned ldsw = (unsigned)wid * 1024u;
    const int aoff = lds_byte(wr * 64 + fr, fq * 8), boff = lds_byte(wc * 32 + fr, fq * 8);
#define PG8_SA(b, h) (((b) * 2 + (h)) * HTB)
#define PG8_SB(b, h) ((4 + (b) * 2 + (h)) * HTB)
#define PG8_STAGE(bufoff, gbase, voff) do { _Pragma("unroll") for (int _i = 0; _i < 2; ++_i) \
        __builtin_amdgcn_global_load_lds((const unsigned*)((const char*)(gbase) + (voff)[_i]), (LAS unsigned*)(lds + (bufoff) + ldsw + _i * 8192), 16, 0, 0); } while (0)
#define PG8_LDA(dst, b, h) do { _Pragma("unroll") for (int m = 0; m < 4; ++m) { if constexpr (FP8) dst##8[m] = cat8(*(const LAS bf16x8*)(lds + PG8_SA(b, h) + aoff + m * 2048), *(const LAS bf16x8*)(lds + PG8_SA(b, h) + aoff + m * 2048 + 1024)); \
        else { _Pragma("unroll") for (int k = 0; k < 2; ++k) dst[m][k] = *(const LAS bf16x8*)(lds + PG8_SA(b, h) + aoff + m * 2048 + k * 1024); } } } while (0)
#define PG8_LDB(dst, b, h) do { _Pragma("unroll") for (int n = 0; n < 2; ++n) { if constexpr (FP8) dst##8[n] = cat8(*(const LAS bf16x8*)(lds + PG8_SB(b, h) + boff + n * 2048), *(const LAS bf16x8*)(lds + PG8_SB(b, h) + boff + n * 2048 + 1024)); \
        else { _Pragma("unroll") for (int k = 0; k < 2; ++k) dst[n][k] = *(const LAS bf16x8*)(lds + PG8_SB(b, h) + boff + n * 2048 + k * 1024); } } } while (0)
#define PG8_MMA(ai, bj, At, Bt) do { __builtin_amdgcn_s_setprio(1); _Pragma("unroll") for (int m = 0; m < 4; ++m) _Pragma("unroll") for (int n = 0; n < 2; ++n) { \
        if constexpr (FP8) acc[ai][bj][m][n] = __builtin_amdgcn_mfma_scale_f32_16x16x128_f8f6f4(Bt##8[n], At##8[m], acc[ai][bj][m][n], 0, 0, 0, 0, 0, 0); \
        else if constexpr (MODE == 2) { _Pragma("unroll") for (int k = 0; k < 2; ++k) acc[ai][bj][m][n] = __builtin_bit_cast(f32x4, __builtin_amdgcn_mfma_i32_16x16x64_i8(__builtin_bit_cast(i32x4, Bt[n][k]), __builtin_bit_cast(i32x4, At[m][k]), __builtin_bit_cast(i32x4, acc[ai][bj][m][n]), 0, 0, 0)); } \
        else { _Pragma("unroll") for (int k = 0; k < 2; ++k) acc[ai][bj][m][n] = __builtin_amdgcn_mfma_f32_16x16x32_bf16(Bt[n][k], At[m][k], acc[ai][bj][m][n], 0, 0, 0); } } \
        __builtin_amdgcn_s_setprio(0); } while (0)
#define PG8_WAIT_V(n) asm volatile("s_waitcnt vmcnt(" #n ")" ::: "memory")
#define PG8_WAIT_L(n) asm volatile("s_waitcnt lgkmcnt(" #n ")" ::: "memory")
#define PG8_BAR __builtin_amdgcn_s_barrier()
#define PG8_SCHED __builtin_amdgcn_sched_barrier(0)
    Unit cur, nxt; int ui = 0;
    if (!S.next(0, cur)) return;
    f32x4 acc[2][2][4][2];
#pragma unroll
    for (int a = 0; a < 2; ++a)
#pragma unroll
        for (int b = 0; b < 2; ++b)
#pragma unroll
            for (int m = 0; m < 4; ++m)
#pragma unroll
                for (int n = 0; n < 2; ++n) acc[a][b][m][n] = (f32x4){0.f, 0.f, 0.f, 0.f};
    bf16x8 At[4][2], B0[2][2], B1[2][2]; i32x8 At8[4], B08[2], B18[2];
    const char* cA = (const char*)g.A + (size_t)cur.pm * tstep + (size_t)cur.k0 * kstep; const char* cB = (const char*)g.Bt + (size_t)cur.pn * tstep + (size_t)cur.k0 * kstep;
    S.a_ready(cur);
    if constexpr (SP2) {
        PG8_STAGE(PG8_SB(0, 0), cB, voffB); PG8_STAGE(PG8_SB(0, 1), cB + hstep, voffB); PG8_STAGE(PG8_SA(0, 0), cA, voffA); PG8_STAGE(PG8_SA(0, 1), cA + hstep, voffA);
        if (wr == 1) PG8_BAR;
        PG8_WAIT_V(2); PG8_BAR;
        PG8_STAGE(PG8_SB(1, 0), cB + kstep, voffB); PG8_STAGE(PG8_SA(1, 0), cA + kstep, voffA); PG8_STAGE(PG8_SB(1, 1), cB + hstep + kstep, voffB);
        PG8_WAIT_V(6); PG8_BAR;
    } else {
        PG8_STAGE(PG8_SB(0, 0), cB, voffB); PG8_STAGE(PG8_SA(0, 0), cA, voffA); PG8_STAGE(PG8_SB(0, 1), cB + hstep, voffB); PG8_STAGE(PG8_SA(0, 1), cA + hstep, voffA);
        if (wr == 1) PG8_BAR;
        PG8_WAIT_V(4); PG8_BAR;
        PG8_STAGE(PG8_SB(1, 0), cB + kstep, voffB); PG8_STAGE(PG8_SA(1, 0), cA + kstep, voffA); PG8_STAGE(PG8_SB(1, 1), cB + hstep + kstep, voffB);
        PG8_WAIT_V(6); PG8_BAR;
    }
    for (;;) {
        const bool has_next = S.next(ui + 1, nxt);
        const char* nA = has_next ? (const char*)g.A + (size_t)nxt.pm * tstep + (size_t)nxt.k0 * kstep : cA; const char* nB = has_next ? (const char*)g.Bt + (size_t)nxt.pn * tstep + (size_t)nxt.k0 * kstep : cB;
        const int nt = cur.nt;
        for (int t = 0; t < nt; t += 2) {
            if constexpr (Epi::PERM) asm volatile("" : "+v"(voffA[0]), "+v"(voffA[1]), "+v"(voffB[0]), "+v"(voffB[1])); else asm volatile("" : "+v"(voffA[0]), "+v"(voffA[1]));
            const bool last = (t == nt - 2);
            const char* a1 = cA + (size_t)(t + 1) * kstep;
            const char* a2 = last ? nA : cA + (size_t)(t + 2) * kstep; const char* b2 = last ? nB : cB + (size_t)(t + 2) * kstep;
            const char* a3 = a2 + kstep; const char* b3 = b2 + kstep;
            if (last && has_next) S.a_ready(nxt);
            if constexpr (SP2) {
            PG8_LDB(B0, 0, 0); PG8_LDB(B1, 0, 1); PG8_SCHED; PG8_LDA(At, 0, 0); PG8_STAGE(PG8_SA(1, 1), a1 + hstep, voffA);
            PG8_WAIT_V(8); PG8_WAIT_L(0); PG8_BAR; PG8_MMA(0, 0, At, B0); PG8_MMA(0, 1, At, B1); PG8_BAR; PG8_SCHED;
            PG8_LDA(At, 0, 1); PG8_STAGE(PG8_SB(0, 0), b2, voffB); PG8_STAGE(PG8_SB(0, 1), b2 + hstep, voffB); PG8_STAGE(PG8_SA(0, 0), a2, voffA);
            PG8_WAIT_V(8); PG8_WAIT_L(0); PG8_BAR; PG8_MMA(1, 0, At, B0); PG8_MMA(1, 1, At, B1); PG8_BAR; PG8_SCHED;
            PG8_LDB(B0, 1, 0); PG8_LDB(B1, 1, 1); PG8_SCHED; PG8_LDA(At, 1, 0); PG8_STAGE(PG8_SA(0, 1), a2 + hstep, voffA);
            PG8_WAIT_V(8); PG8_WAIT_L(0); PG8_BAR; PG8_MMA(0, 0, At, B0); PG8_MMA(0, 1, At, B1); PG8_BAR; PG8_SCHED;
            PG8_LDA(At, 1, 1); PG8_STAGE(PG8_SB(1, 0), b3, voffB); PG8_STAGE(PG8_SB(1, 1), b3 + hstep, voffB); PG8_STAGE(PG8_SA(1, 0), a3, voffA);
            PG8_WAIT_V(8); PG8_WAIT_L(0); PG8_BAR; PG8_MMA(1, 0, At, B0); PG8_MMA(1, 1, At, B1); PG8_BAR; PG8_SCHED;
            } else {
            PG8_LDB(B0, 0, 0); PG8_SCHED; PG8_LDA(At, 0, 0); PG8_STAGE(PG8_SA(1, 1), a1 + hstep, voffA);
            PG8_WAIT_L(8); PG8_BAR; PG8_WAIT_L(0); PG8_MMA(0, 0, At, B0); PG8_BAR; PG8_SCHED;
            PG8_LDB(B1, 0, 1); PG8_STAGE(PG8_SB(0, 0), b2, voffB);
            PG8_BAR; PG8_WAIT_L(0); PG8_MMA(0, 1, At, B1); PG8_BAR;
            PG8_LDA(At, 0, 1); PG8_STAGE(PG8_SA(0, 0), a2, voffA);
            PG8_BAR; PG8_WAIT_L(0); PG8_MMA(1, 0, At, B0); PG8_BAR; PG8_SCHED;
            PG8_STAGE(PG8_SB(0, 1), b2 + hstep, voffB);
            PG8_WAIT_V(6); PG8_BAR; PG8_MMA(1, 1, At, B1); PG8_BAR;
            PG8_LDB(B0, 1, 0); PG8_SCHED; PG8_LDA(At, 1, 0); PG8_STAGE(PG8_SA(0, 1), a2 + hstep, voffA);
            PG8_WAIT_L(8); PG8_BAR; PG8_WAIT_L(0); PG8_MMA(0, 0, At, B0); PG8_BAR; PG8_SCHED;
            PG8_LDB(B1, 1, 1); PG8_STAGE(PG8_SB(1, 0), b3, voffB);
            PG8_BAR; PG8_WAIT_L(0); PG8_MMA(0, 1, At, B1); PG8_BAR;
            PG8_LDA(At, 1, 1); PG8_STAGE(PG8_SA(1, 0), a3, voffA);
            PG8_BAR; PG8_WAIT_L(0); PG8_MMA(1, 0, At, B0); PG8_BAR; PG8_SCHED;
            PG8_STAGE(PG8_SB(1, 1), b3 + hstep, voffB);
            PG8_WAIT_V(6); PG8_BAR; PG8_MMA(1, 1, At, B1); PG8_BAR;
            }
        }
        if constexpr (ALIGN_EPI) { if (wr == 0) PG8_BAR; }
        { const int te_ = lane_now(); E(acc, cur, wr, wc, te_ & 15, (te_ >> 4) & 3); } S.done(cur);
        if (!has_next) break;
#pragma unroll
        for (int a = 0; a < 2; ++a)
#pragma unroll
            for (int b = 0; b < 2; ++b)
#pragma unroll
                for (int m = 0; m < 4; ++m)
#pragma unroll
                    for (int n = 0; n < 2; ++n) acc[a][b][m][n] = (f32x4){0.f, 0.f, 0.f, 0.f};
        cur = nxt; cA = nA; cB = nB; ++ui;
        if constexpr (ALIGN_EPI) { if (wr == 1) PG8_BAR; }
    }
    PG8_WAIT_V(0);
    if constexpr (!ALIGN_EPI) { if (wr == 0) PG8_BAR; }
    PG8_BAR;
#undef PG8_SA
#undef PG8_SB
#undef PG8_STAGE
#undef PG8_LDA
#undef PG8_LDB
#undef PG8_MMA
#undef PG8_WAIT_V
#undef PG8_WAIT_L
#undef PG8_BAR
#undef PG8_SCHED
}
}

constexpr int LDS_BYTES = 160 * 1024;
constexpr int MISC_OFF = LDS_BYTES - 256;
constexpr int L_QS = 0, L_KK = 17408, L_VBT = 34816, L_KBGT = 53248, L_MS = 71680, L_ATT = 88064, L_KDT = 97280, L_TT = 115712, L_SM = 124928, L_UT = 125952, L_RED = 144384;
constexpr int L_W = L_KK, L_ST = 34816, L_VNT = 69632;
static_assert(L_VNT + IMG_VNT <= L_ATT && L_RED + 2048 <= MISC_OFF, "lds map");
constexpr int SC_STG = 35840, SC_ST = 71680, SC_VNT = 106496;
constexpr int OP_QD = 0, OP_ATT = 17408, OP_VNT = 26624, OP_H = 45056, OP_RED = 79872;
constexpr int LD128B = 272, LD64B = 144;

#define XB_TMO      128
#define XB_XCNT(j)  (256  + 64 * (j))
#define XB_XSUB(j)  (1280 + 64 * (j))
#define XB_XGEN(j)  (2304 + 64 * (j))
#define XB_TOP      3328
#define XB_TOPGEN   3392
#define XCD_BAR_WORDS 3456
#define XB_SPIN_CAP (1u << 22)
__device__ __forceinline__ unsigned xb_ld(unsigned* p)              { return __hip_atomic_load(p, __ATOMIC_RELAXED, __HIP_MEMORY_SCOPE_AGENT); }
__device__ __forceinline__ unsigned xb_add(unsigned* p, unsigned v) { return __hip_atomic_fetch_add(p, v, __ATOMIC_RELAXED, __HIP_MEMORY_SCOPE_AGENT); }
__device__ __forceinline__ unsigned xb_xcc_id() { return (unsigned)__builtin_amdgcn_s_getreg((3 << 11) | 20) & 0xFu; }
#define XB_SPIN(cond, bar) do { unsigned _sp = 0; while (cond) { __builtin_amdgcn_s_sleep(1); \
    if ((++_sp & 255u) == 0u) { if (xb_ld(&(bar)[XB_TMO])) break; if (_sp > XB_SPIN_CAP) { atomicAdd(&(bar)[XB_TMO], 1u); break; } } } } while (0)
struct XcdBarrier { unsigned* bar; unsigned x; volatile LAS unsigned* st; };
__device__ __forceinline__ XcdBarrier xcd_barrier_post(unsigned* bar, volatile LAS unsigned* st, const int wave_s) {
    XcdBarrier b; b.bar = bar; b.x = xb_xcc_id(); b.st = st;
    if (TID_NOW(wave_s) == 0) (void)xb_add(&bar[XB_XCNT(b.x)], 1u);
    return b;
}
__device__ __forceinline__ void xcd_barrier_complete(unsigned* bar, unsigned x, unsigned& nloc, unsigned& nx) {
    const unsigned G = gridDim.x * gridDim.y * gridDim.z;
    unsigned sum, cnt, mine, sp = 0u;
    for (;;) {
        sum = 0u; cnt = 0u; mine = 0u;
#pragma unroll
        for (unsigned j = 0; j < 16; ++j) { const unsigned c = xb_ld(&bar[XB_XCNT(j)]); sum += c; cnt += (c > 0u) ? 1u : 0u; mine = (j == x) ? c : mine; }
        if (sum == G) break;
        __builtin_amdgcn_s_sleep(1);
        if ((++sp & 255u) == 0u) { if (xb_ld(&bar[XB_TMO])) break; if (sp > XB_SPIN_CAP) { atomicAdd(&bar[XB_TMO], 1u); break; } }
    }
    nloc = mine > 0u ? mine : 1u; nx = cnt > 0u ? cnt : 1u;
}
__device__ __forceinline__ void xcd_barrier(const XcdBarrier& b, const int wave_s) {
    asm volatile("s_waitcnt vmcnt(0)" ::: "memory");
    __syncthreads();
    if (TID_NOW(wave_s) == 0) {
        unsigned* bar = b.bar;
        __builtin_amdgcn_s_waitcnt(0);
        unsigned nloc = b.st[0], nx = b.st[1];
        if (nloc == 0u) { xcd_barrier_complete(bar, b.x, nloc, nx); b.st[0] = nloc; b.st[1] = nx; }
        const unsigned old = xb_add(&bar[XB_XSUB(b.x)], 1u);
        const unsigned gen = old / nloc;
        if (old + 1u == (gen + 1u) * nloc) {
            __builtin_amdgcn_fence(__ATOMIC_RELEASE, "agent");
            asm volatile("s_waitcnt vmcnt(0)" ::: "memory");
            const unsigned og = xb_add(&bar[XB_TOP], 1u);
            const unsigned tg = og / nx;
            if (og + 1u == (tg + 1u) * nx) xb_add(&bar[XB_TOPGEN], 1u);
            else XB_SPIN(xb_ld(&bar[XB_TOPGEN]) == tg, bar);
            __builtin_amdgcn_fence(__ATOMIC_ACQUIRE, "agent");
            xb_add(&bar[XB_XGEN(b.x)], 1u);
            asm volatile("s_waitcnt vmcnt(0)" ::: "memory");
        } else {
            XB_SPIN(xb_ld(&bar[XB_XGEN(b.x)]) == gen, bar);
            __builtin_amdgcn_fence(__ATOMIC_ACQUIRE, "agent");
            asm volatile("s_waitcnt vmcnt(0)" ::: "memory");
        }
    }
    __syncthreads();
}

struct Args { const float* in[20]; float* out; uchar* ws; int ph_lo, ph_hi; };

#define STG_T0() ((void)0)
#define STG(n) ((void)0)
#define PROBE_STAGE 0
struct Frame {
    LAS uchar* lds;
    int tid, lane, wave, vcu, G;
    const GAS float* const* in; GAS float* out; GAS uchar* ws;
};
constexpr int I_XP = 0, I_XS = 1, I_SCA = 2, I_SGC = 3, I_SG = 4, I_WIN = 5, I_CAW = 6, I_GCW = 7, I_ALOG = 8, I_DTB = 9, I_GNW = 10, I_WA = 11, I_WB = 12, I_WO = 13,
              I_L1G = 14, I_L1B = 15, I_WUP = 16, I_WD = 17, I_L2G = 18, I_L2B = 19;

struct TrJob { const GAS float* W; GAS bf16_t* WT; int K, ldw, row_off, nblk; float fp8; GAS uchar* WT8; };
__device__ __forceinline__ void tr_load(const TrJob& j, int item, int lane, f32x4 (&v)[8]) {
    const int kb = item / j.nblk, nb = item - kb * j.nblk; const GAS float* src = j.W + (size_t)(64 * kb + (lane >> 3)) * j.ldw + 32 * nb + 4 * (lane & 7);
#pragma unroll
    for (int i = 0; i < 8; ++i) v[i] = *(const GAS f32x4*)(src + (size_t)(8 * i) * j.ldw);
}
__device__ __forceinline__ void tr_store(const TrJob& j, int item, int lane, const f32x4 (&v)[8], LAS float* scr) {
    const int kb = item / j.nblk, nb = item - kb * j.nblk, k0 = 64 * kb, n0 = 32 * nb;
#pragma unroll
    for (int i = 0; i < 8; ++i) { LAS float* d = scr + (8 * i + (lane >> 3)) * 33 + 4 * (lane & 7); d[0] = v[i][0]; d[1] = v[i][1]; d[2] = v[i][2]; d[3] = v[i][3]; }
    LDS_WAIT(); asm volatile("" ::: "memory");
    const int c = lane & 7;
#pragma unroll
    for (int jj = 0; jj < 4; ++jj) { const int n = (lane >> 3) + 8 * jj; const LAS float* sp = scr + (8 * c) * 33 + n;
        if (j.fp8 < 0.f) { const float sc = -j.fp8;
            *(GAS u32x2*)((GAS uchar*)j.WT + (size_t)(j.row_off + n0 + n) * j.K + k0 + 8 * c) = (u32x2){pk4_i8(sp[0 * 33] * sc, sp[1 * 33] * sc, sp[2 * 33] * sc, sp[3 * 33] * sc), pk4_i8(sp[4 * 33] * sc, sp[5 * 33] * sc, sp[6 * 33] * sc, sp[7 * 33] * sc)};
        } else if (j.fp8 > 0.f) { const float sc = j.fp8;
            *(GAS u32x2*)((GAS uchar*)j.WT + (size_t)(j.row_off + n0 + n) * j.K + k0 + 8 * c) = (u32x2){pk4_fp8(sp[0 * 33] * sc, sp[1 * 33] * sc, sp[2 * 33] * sc, sp[3 * 33] * sc), pk4_fp8(sp[4 * 33] * sc, sp[5 * 33] * sc, sp[6 * 33] * sc, sp[7 * 33] * sc)};
        } else {
        u32x4 o; o.x = pk2(sp[0 * 33], sp[1 * 33]); o.y = pk2(sp[2 * 33], sp[3 * 33]); o.z = pk2(sp[4 * 33], sp[5 * 33]); o.w = pk2(sp[6 * 33], sp[7 * 33]);
        *(GAS u32x4*)(j.WT + (size_t)(j.row_off + n0 + n) * j.K + k0 + 8 * c) = o;
        if (j.WT8) { const float sc = pg8::WIN_SCALE;
            *(GAS u32x2*)(j.WT8 + (size_t)(j.row_off + n0 + n) * j.K + k0 + 8 * c) = (u32x2){pk4_i8(sp[0 * 33] * sc, sp[1 * 33] * sc, sp[2 * 33] * sc, sp[3 * 33] * sc), pk4_i8(sp[4 * 33] * sc, sp[5 * 33] * sc, sp[6 * 33] * sc, sp[7 * 33] * sc)}; } } }
    LDS_WAIT(); asm volatile("" ::: "memory");
}
__device__ __forceinline__ TrJob tr_job(Frame& F, int l, int it, int& r) {
    constexpr int J0 = 32 * 224, J1 = 32 * 128, J2 = 16 * 64, J3 = 16 * 64, J4 = 32 * 64, J5 = 32 * 256;
    const GAS float* win = F.in[I_WIN] + (size_t)l * DM * NPROJ_REF;
    r = it;
    if (r < J0) return TrJob{win, (GAS bf16_t*)(F.ws + WS_WIN), DM, NPROJ_REF, 0, 224, 0.f, F.ws + WS_WIN8}; r -= J0;
    if (r < J1) return TrJob{win + 7184, (GAS bf16_t*)(F.ws + WS_WIN), DM, NPROJ_REF, 7168, 128, 0.f, F.ws + WS_WIN8}; r -= J1;
    if (r < J2) return TrJob{F.in[I_WA] + (size_t)l * DCONV * DM, (GAS bf16_t*)(F.ws + WS_WA), DCONV, DM, 0, 64, 0.f, nullptr}; r -= J2;
    if (r < J3) return TrJob{F.in[I_WB] + (size_t)l * DGDN * DM, (GAS bf16_t*)(F.ws + WS_WB), DGDN, DM, 0, 64, 0.f, nullptr}; r -= J3;
    if (r < J4) return TrJob{F.in[I_WO] + (size_t)l * DM * DM, (GAS bf16_t*)(F.ws + WS_WO), DM, DM, 0, 64, -pg8::WO_SCALE, nullptr}; r -= J4;
    if (r < J5) return TrJob{F.in[I_WUP] + (size_t)l * DM * DFF, (GAS bf16_t*)(F.ws + WS_WUP), DM, DFF, 0, 256, -pg8::WUP_SCALE, nullptr}; r -= J5;
    return TrJob{F.in[I_WD] + (size_t)l * DFF * DM, (GAS bf16_t*)(F.ws + WS_WD), DFF, DM, 0, 64, -pg8::WD_SCALE, nullptr};
}
__device__ __forceinline__ void phase_conv(Frame& F, int l) {
    LAS float* scr = (LAS float*)(F.lds + F.wave * 16384);
    const int gw = F.vcu * 8 + F.wave, NGW = F.G * 8;
    const GAS float* win = F.in[I_WIN] + (size_t)l * DM * NPROJ_REF;
    constexpr int NITEMS = 32 * 224 + 32 * 128 + 16 * 64 + 16 * 64 + 32 * 64 + 32 * 256 + 128 * 64;
    {
        f32x4 va[8], vb[8]; int it = gw, ra = 0, rb = 0; TrJob ja{}, jb{};
        if (it < NITEMS) { ja = tr_job(F, l, it, ra); tr_load(ja, ra, F.lane, va); }
        while (it < NITEMS) {
            const int nx = it + NGW;
            if (nx < NITEMS) { jb = tr_job(F, l, nx, rb); tr_load(jb, rb, F.lane, vb); }
            tr_store(ja, ra, F.lane, va, scr);
            it = nx; if (it >= NITEMS) break;
            const int nx2 = it + NGW;
            if (nx2 < NITEMS) { ja = tr_job(F, l, nx2, ra); tr_load(ja, ra, F.lane, va); }
            tr_store(jb, rb, F.lane, vb, scr);
            it = nx2;
        }
    }
    { GAS float* wlg = (GAS float*)(F.ws + WS_WLG); const int gt = F.vcu * 512 + F.tid, NT = F.G * 512;
      for (int e = gt; e < 16 * DM; e += NT) { const int j = e & 15, k = e >> 4; wlg[j * DM + k] = win[(size_t)k * NPROJ_REF + 7168 + j]; } }
    if (l == 0) {
        GAS bf16_t* xb = (GAS bf16_t*)(F.ws + WS_XB);
        for (int m = gw; m < MT; m += NGW) {
            const GAS float* xr = (m < MP) ? F.in[I_XP] + (size_t)m * DM : F.in[I_XS] + (size_t)(m - MP) * DM;
#pragma unroll
            for (int j = 0; j < 4; ++j) { const f32x4 a = *(const GAS f32x4*)(xr + j * 512 + F.lane * 8), b = *(const GAS f32x4*)(xr + j * 512 + F.lane * 8 + 4);
                u32x4 o; o.x = pk2(a[0], a[1]); o.y = pk2(a[2], a[3]); o.z = pk2(b[0], b[1]); o.w = pk2(b[2], b[3]);
                *(GAS u32x4*)(xb + (size_t)m * DM + j * 512 + F.lane * 8) = o;
                const float sq = pg8::XQ_SCALE;
                *(GAS u32x2*)(F.ws + WS_XB8 + (size_t)m * DM + j * 512 + F.lane * 8) = (u32x2){pk4_i8(a[0] * sq, a[1] * sq, a[2] * sq, a[3] * sq), pk4_i8(b[0] * sq, b[1] * sq, b[2] * sq, b[3] * sq)}; }
        }
    }
}

__device__ __forceinline__ void phase_logits(Frame& F, int l) {
    const int gw = F.vcu * 8 + F.wave, NGW = F.G * 8;
    const GAS float* wlg = (const GAS float*)(F.ws + WS_WLG); GAS float* lg = (GAS float*)(F.ws + WS_LG);
    for (int m0 = 4 * gw; m0 < MT; m0 += 4 * NGW) {
        const GAS float* xr = (l == 0) ? ((m0 < MP) ? F.in[I_XP] + (size_t)m0 * DM : F.in[I_XS] + (size_t)(m0 - MP) * DM) : (const GAS float*)(F.ws + WS_X) + (size_t)m0 * DM;
        float acc[4][16];
#pragma unroll
        for (int r = 0; r < 4; ++r)
#pragma unroll
            for (int j = 0; j < 16; ++j) acc[r][j] = 0.f;
#pragma unroll 1
        for (int kk = 0; kk < 8; ++kk) { const int k = kk * 256 + F.lane * 4; f32x4 xv[4];
#pragma unroll
            for (int r = 0; r < 4; ++r) xv[r] = *(const GAS f32x4*)(xr + (size_t)r * DM + k);
#pragma unroll
            for (int j = 0; j < 16; ++j) { const f32x4 wv = *(const GAS f32x4*)(wlg + j * DM + k);
#pragma unroll
                for (int r = 0; r < 4; ++r) acc[r][j] += xv[r][0] * wv[0] + xv[r][1] * wv[1] + xv[r][2] * wv[2] + xv[r][3] * wv[3]; } }
        float mine = 0.f;
#pragma unroll
        for (int r = 0; r < 4; ++r)
#pragma unroll
            for (int j = 0; j < 16; ++j) { const float sm_ = wave_sum(acc[r][j]); if (F.lane == r * 16 + j) mine = sm_; }
        lg[(size_t)m0 * 16 + F.lane] = mine;
    }
}

__device__ __forceinline__ void mixa_unit(Frame& F, int l, int u) {
    const GAS bf16_t* P = (const GAS bf16_t*)(F.ws + WS_P); GAS bf16_t* ain = (GAS bf16_t*)(F.ws + WS_AIN);
    const int c = 2 * F.tid;
    const GAS float* cw = F.in[I_CAW] + (size_t)l * 3 * DCONV;
    const f32x2 w0 = *(const GAS f32x2*)(cw + c), w1 = *(const GAS f32x2*)(cw + DCONV + c), w2 = *(const GAS f32x2*)(cw + 2 * DCONV + c);
    f32x2 um2 = {0.f, 0.f}, um1 = {0.f, 0.f};
    int row0, nrows; GAS float* so; int so_first;
    if (u < 256) { const int b = u >> 6, blk = u & 63; row0 = b * SEQ + blk * 32; nrows = 32;
        if (blk > 0) {
#pragma unroll
            for (int r = 0; r < 2; ++r) { const GAS bf16_t* pr = P + (size_t)(row0 - 2 + r) * NPROJ; const unsigned gc = *(const GAS unsigned*)(pr + CC + c), hh = *(const GAS unsigned*)(pr + CHH + c);
                const f32x2 uu = {bflo(gc) * bflo(hh), bfhi(gc) * bfhi(hh)}; if (r == 0) um2 = uu; else um1 = uu; } }
        so = (blk == 63) ? F.out + O_CAP + (size_t)((l * NPB + b) * 2) * DCONV : nullptr; so_first = 30;
    } else { const int b = u - 256; row0 = MP + b * SSEQ; nrows = SSEQ;
        const GAS float* st = F.in[I_SCA] + (size_t)((l * NSB + b) * 2) * DCONV;
        um2 = *(const GAS f32x2*)(st + c); um1 = *(const GAS f32x2*)(st + DCONV + c);
        so = F.out + O_CAS + (size_t)((l * NSB + b) * 2) * DCONV; so_first = 2;
    }
#pragma unroll 2
    for (int t0 = 0; t0 < nrows; t0 += 4) {
        unsigned gb[4], gc[4], hh[4];
#pragma unroll
        for (int j = 0; j < 4; ++j) { const GAS bf16_t* pr = P + (size_t)(row0 + t0 + j) * NPROJ;
            gb[j] = *(const GAS unsigned*)(pr + CB + c); gc[j] = *(const GAS unsigned*)(pr + CC + c); hh[j] = *(const GAS unsigned*)(pr + CHH + c); }
#pragma unroll
        for (int j = 0; j < 4; ++j) { const int t = t0 + j;
            const f32x2 uu = {bflo(gc[j]) * bflo(hh[j]), bfhi(gc[j]) * bfhi(hh[j])};
            const f32x2 cv = w0 * um2 + w1 * um1 + w2 * uu;
            *(GAS unsigned*)(ain + (size_t)(row0 + t) * DCONV + c) = pk2(bflo(gb[j]) * cv[0], bfhi(gb[j]) * cv[1]);
            if (so && t >= so_first) *(GAS f32x2*)(so + (size_t)(t - so_first) * DCONV + c) = uu;
            um2 = um1; um1 = uu; }
    }
}

struct PrepIn { int l, h, row0, nvalid, halo_mode  ; const GAS float* hs; GAS float* gc_out; int gc_i0; };
template <int NI>
__device__ __forceinline__ void gdn_prepare(Frame& F, const PrepIn& q) {
    LAS uchar* lds = F.lds; const int lane = F.lane, wave = F.wave, fr = lane & 15, fq = lane >> 4;
    const GAS bf16_t* P = (const GAS bf16_t*)(F.ws + WS_P);
    LAS float* sm = (LAS float*)(lds + L_SM);
    STG_T0();
    if (wave == 0) {
        const int i = lane; float g = 0.f, beta = 0.f;
        if (i < q.nvalid) { const GAS float* lgp = (const GAS float*)(F.ws + WS_LG) + (size_t)(q.row0 + i) * 16;
            const float bl = lgp[q.h], al = lgp[8 + q.h];
            beta = sigmoidf_(bl);
            const float xx = al + F.in[I_DTB][q.l * NH + q.h]; const float sp = softplusf_(xx);
            g = -__expf(F.in[I_ALOG][q.l * NH + q.h]) * sp; }
        float gc = g;
#pragma unroll
        for (int o = 1; o < 64; o <<= 1) { const float t = __builtin_bit_cast(float, __builtin_amdgcn_ds_bpermute(4 * (lane - o), __builtin_bit_cast(int, gc))); if (lane >= o) gc += t; }
        sm[i] = beta; sm[64 + i] = gc; if (i == 63) sm[128] = gc;
    }
    LBAR(); STG(1);
    {
        const int i0 = 8 * wave; const GAS float* cwb = F.in[I_GCW] + (size_t)q.l * 4 * 3 * DGDN;
        const bool st_halo = (q.halo_mode == 2) && (i0 == 0);
        unsigned raw3[3][11]; f32x2 hal3[3][3]; f32x2 cw3[3][4];
#pragma unroll
        for (int s = 0; s < 3; ++s) {
            const int chan = s * DGDN + q.h * HD + 2 * lane, pcol = CQ + chan;
#pragma unroll
            for (int j = 0; j < 4; ++j) cw3[s][j] = *(const GAS f32x2*)(cwb + (size_t)j * 3 * DGDN + chan);
#pragma unroll
            for (int r = 0; r < 11; ++r) { const int i = i0 - 3 + r; const bool ok = (i >= 0) ? (i < q.nvalid) : (q.halo_mode == 1);
                const int rowi = (q.row0 + i) < 0 ? 0 : (q.row0 + i);
                const unsigned w_ = *(const GAS unsigned*)(P + (size_t)rowi * NPROJ + pcol); raw3[s][r] = ok ? w_ : 0u; }
#pragma unroll
            for (int r = 0; r < 3; ++r) { hal3[s][r] = (f32x2){0.f, 0.f}; if (st_halo) hal3[s][r] = *(const GAS f32x2*)(q.hs + (size_t)r * 3 * DGDN + chan); }
        }
#pragma unroll
        for (int s = 0; s < 3; ++s) {
            const int chan = s * DGDN + q.h * HD + 2 * lane;
            f32x2 cw[4]; unsigned raw[11]; f32x2 hal[3];
#pragma unroll
            for (int j = 0; j < 4; ++j) cw[j] = cw3[s][j];
#pragma unroll
            for (int r = 0; r < 11; ++r) raw[r] = raw3[s][r];
#pragma unroll
            for (int r = 0; r < 3; ++r) hal[r] = hal3[s][r];
            f32x2 xv[11];
#pragma unroll
            for (int r = 0; r < 11; ++r) { xv[r] = (f32x2){bflo(raw[r]), bfhi(raw[r])}; if (r < 3 && st_halo) xv[r] = hal[r]; }
            if (q.gc_out) {
#pragma unroll
                for (int r = 3; r < 11; ++r) { const int i = i0 - 3 + r; if (i >= q.gc_i0 && i < q.gc_i0 + 3) *(GAS f32x2*)(q.gc_out + (size_t)(i - q.gc_i0) * 3 * DGDN + chan) = xv[r]; } }
            unsigned prev = 0u;
#pragma unroll
            for (int rr = 0; rr < 8; ++rr) {
                const int i = i0 + rr;
                f32x2 y = cw[0] * xv[rr] + cw[1] * xv[rr + 1] + cw[2] * xv[rr + 2] + cw[3] * xv[rr + 3];
                y[0] = siluf_(y[0]); y[1] = siluf_(y[1]);
                if (i >= q.nvalid) y = (f32x2){0.f, 0.f};
                const float beta = sm[i], gc = sm[64 + i];
                if (s == 0) { const float ss = wave_sum(y[0] * y[0] + y[1] * y[1]); const float rn = rsqrtf(ss + NORM_EPS) * 0.08838834764831845f;
                    *(LAS unsigned*)(lds + L_QS + i * LD128B + 4 * lane) = pk2(y[0] * rn, y[1] * rn); }
                else if (s == 1) { const float ss = wave_sum(y[0] * y[0] + y[1] * y[1]); const float rn = rsqrtf(ss + NORM_EPS);
                    const float k0 = y[0] * rn, k1 = y[1] * rn;
                    *(LAS unsigned*)(lds + L_KK + i * LD128B + 4 * lane) = pk2(k0, k1);
                    const float sc = beta * __expf(gc); const unsigned cur = pk2(k0 * sc, k1 * sc);
                    if (rr & 1) { *(LAS unsigned*)(lds + L_KBGT + (2 * lane) * LD64B + 2 * (i - 1)) = (prev & 0xffffu) | (cur << 16);
                                  *(LAS unsigned*)(lds + L_KBGT + (2 * lane + 1) * LD64B + 2 * (i - 1)) = (prev >> 16) | (cur & 0xffff0000u); }
                    prev = cur; }
                else { const unsigned cur = pk2(y[0] * beta, y[1] * beta);
                    if (rr & 1) { *(LAS unsigned*)(lds + L_VBT + (2 * lane) * LD64B + 2 * (i - 1)) = (prev & 0xffffu) | (cur << 16);
                                  *(LAS unsigned*)(lds + L_VBT + (2 * lane + 1) * LD64B + 2 * (i - 1)) = (prev >> 16) | (cur & 0xffff0000u); }
                    prev = cur; }
            }
        }
    }
    LBAR(); STG(2);
    for (int job = wave; job < 32; job += 8) {
        const bool isM = job < 16; const int jj = job & 15, ti = jj >> 2, tj = jj & 3;
        if (tj > ti) { if (!isM) {
#pragma unroll
                for (int reg = 0; reg < 4; ++reg) *(LAS bf16_t*)(lds + L_ATT + (16 * ti + 4 * fq + reg) * LD64B + 2 * (16 * tj + fr)) = (bf16_t)0; }
            continue; }
        f32x4 acc = {0.f, 0.f, 0.f, 0.f};
        const int abase = (isM ? L_KK : L_QS) + (16 * ti + fr) * LD128B + 16 * fq, bbase = L_KK + (16 * tj + fr) * LD128B + 16 * fq;
#pragma unroll
        for (int kk = 0; kk < 4; ++kk) { const bf16x8 a = *(const LAS bf16x8*)(lds + abase + kk * 64), b = *(const LAS bf16x8*)(lds + bbase + kk * 64);
            acc = __builtin_amdgcn_mfma_f32_16x16x32_bf16(a, b, acc, 0, 0, 0); }
        const int j = 16 * tj + fr; const float gcj = sm[64 + j];
#pragma unroll
        for (int reg = 0; reg < 4; ++reg) { const int i = 16 * ti + 4 * fq + reg; const float gci = sm[64 + i];
            const float d = (i >= j) ? __expf(gci - gcj) : 0.f;
            if (isM) *(LAS float*)(lds + L_MS + (i * 64 + j) * 4) = (i > j) ? sm[i] * acc[reg] * d : 0.f;
            else *(LAS bf16_t*)(lds + L_ATT + i * LD64B + 2 * j) = (bf16_t)(pk2(acc[reg] * d, 0.f) & 0xffffu); }
    }
    LBAR(); STG(3);
    constexpr int L_CB = L_UT, L_AT = L_UT + 2560, L_XT = L_UT + 5120, LDC = 80;
    if (wave == 0) {
        if constexpr (NI == 64) {
            float Tc[32]; int lv = lane & 31; const int hb = lane >> 5, rb = 32 * hb;
            const LAS uchar* msb = lds + L_MS + (rb * 64 + rb) * 4; asm volatile("" : "+v"(msb));
            LAS uchar* ttb = lds + L_TT + rb * LD64B + 2 * (rb + (lane & 31)); asm volatile("" : "+v"(ttb));
            LAS uchar* atb = lds + L_AT + (lane & 31) * LDC; asm volatile("" : "+v"(atb));
#pragma unroll
            for (int i = 0; i < 32; ++i) {
                float a0 = 0.f, a1 = 0.f, a2 = 0.f, a3 = 0.f;
#pragma unroll
                for (int m4 = 0; m4 < i; m4 += 4) { const f32x4 mv = *(const LAS f32x4*)(msb + (i * 64 + m4) * 4);
                    a0 += mv[0] * Tc[m4]; if (m4 + 1 < i) a1 += mv[1] * Tc[m4 + 1]; if (m4 + 2 < i) a2 += mv[2] * Tc[m4 + 2]; if (m4 + 3 < i) a3 += mv[3] * Tc[m4 + 3]; }
                asm volatile("" : "+v"(lv));
                Tc[i] = (i == lv) ? 1.f : -((a0 + a1) + (a2 + a3));
                const bf16_t tb = (bf16_t)(pk2(Tc[i], 0.f) & 0xffffu);
                *(LAS bf16_t*)(ttb + i * LD64B) = tb;
                if (hb == 0) *(LAS bf16_t*)(atb + 2 * i) = tb;
                if ((i & 3) == 3) asm volatile("" ::: "memory");
            }
        } else {
            float Tc[NI]; int lv = lane;
            const LAS uchar* msb = lds + L_MS; asm volatile("" : "+v"(msb));
            LAS uchar* ttb = lds + L_TT + 2 * lane; asm volatile("" : "+v"(ttb));
#pragma unroll
            for (int i = 0; i < NI; ++i) { float a = 0.f;
#pragma unroll
                for (int m = 0; m < i; ++m) a += *(const LAS float*)(msb + (i * 64 + m) * 4) * Tc[m];
                asm volatile("" : "+v"(lv)); Tc[i] = (i == lv) ? 1.f : -a;
                *(LAS bf16_t*)(ttb + i * LD64B) = (bf16_t)(pk2(Tc[i], 0.f) & 0xffffu); }
#pragma unroll 1
            for (int i = NI; i < 64; ++i) *(LAS bf16_t*)(lds + L_TT + i * LD64B + 2 * lane) = (i == lane) ? (bf16_t)0x3f80 : (bf16_t)0;
        }
    } else {
        const int t = F.tid - 64; const float glast = sm[128];
        for (int idx = t; idx < 64 * 64; idx += 448) { const int i = idx >> 6, p = idx & 63; const float e = __expf(sm[64 + i]);
            LAS unsigned* a = (LAS unsigned*)(lds + L_QS + i * LD128B + 4 * p); const unsigned w = *a; *a = pk2(bflo(w) * e, bfhi(w) * e); }
        for (int idx = t; idx < 128 * 32; idx += 448) { const int d = idx & 127, ip = idx >> 7, i = 2 * ip;
            const float k0 = bf1(*(const LAS bf16_t*)(lds + L_KK + i * LD128B + 2 * d)), k1 = bf1(*(const LAS bf16_t*)(lds + L_KK + (i + 1) * LD128B + 2 * d));
            *(LAS unsigned*)(lds + L_KDT + d * LD64B + 4 * ip) = pk2(k0 * __expf(glast - sm[64 + i]), k1 * __expf(glast - sm[65 + i])); }
        if constexpr (NI == 64) {
            for (int idx = t; idx < 32 * 16; idx += 448) { const int i = idx >> 4, mp = idx & 15;
                const f32x2 c2 = *(const LAS f32x2*)(lds + L_MS + ((32 + i) * 64 + 2 * mp) * 4);
                *(LAS unsigned*)(lds + L_CB + i * LDC + 4 * mp) = pk2(c2[0], c2[1]);
                *(LAS unsigned*)(lds + L_TT + i * LD64B + 2 * (32 + 2 * mp)) = 0u; }
        }
    }
    if constexpr (NI == 64) {
        LBAR();
        if (wave < 4) { const int ti = wave >> 1, tj = wave & 1;
            const bf16x8 a = *(const LAS bf16x8*)(lds + L_CB + (16 * ti + fr) * LDC + 16 * fq), b = *(const LAS bf16x8*)(lds + L_AT + (16 * tj + fr) * LDC + 16 * fq);
            const f32x4 x = __builtin_amdgcn_mfma_f32_16x16x32_bf16(a, b, (f32x4){0.f, 0.f, 0.f, 0.f}, 0, 0, 0);
            *(LAS u32x2*)(lds + L_XT + (16 * tj + fr) * LDC + 2 * (16 * ti + 4 * fq)) = (u32x2){pk2(x[0], x[1]), pk2(x[2], x[3])}; }
        LBAR();
        if (wave < 4) { const int ti = wave >> 1, tj = wave & 1;
            const bf16x8 a = *(const LAS bf16x8*)(lds + L_TT + (32 + 16 * ti + fr) * LD64B + 2 * 32 + 16 * fq), b = *(const LAS bf16x8*)(lds + L_XT + (16 * tj + fr) * LDC + 16 * fq);
            const f32x4 x = __builtin_amdgcn_mfma_f32_16x16x32_bf16(a, b, (f32x4){0.f, 0.f, 0.f, 0.f}, 0, 0, 0);
#pragma unroll
            for (int reg = 0; reg < 4; ++reg) *(LAS bf16_t*)(lds + L_TT + (32 + 16 * ti + 4 * fq + reg) * LD64B + 2 * (16 * tj + fr)) = (bf16_t)(pk2(-x[reg], 0.f) & 0xffffu); }
    }
    LBAR(); STG(4);
    for (int job = wave; job < 64; job += 8) {
        f32x4 acc = {0.f, 0.f, 0.f, 0.f};
        if (job < 32) { const int tc = job >> 3, tdv = job & 7;
#pragma unroll
            for (int kk = 0; kk < 2; ++kk) { const bf16x8 a = *(const LAS bf16x8*)(lds + L_TT + (16 * tc + fr) * LD64B + kk * 64 + 16 * fq), b = *(const LAS bf16x8*)(lds + L_VBT + (16 * tdv + fr) * LD64B + kk * 64 + 16 * fq);
                acc = __builtin_amdgcn_mfma_f32_16x16x32_bf16(a, b, acc, 0, 0, 0); }
            *(LAS u32x2*)(lds + L_UT + (16 * tdv + fr) * LD64B + 2 * (16 * tc + 4 * fq)) = (u32x2){pk2(acc[0], acc[1]), pk2(acc[2], acc[3])};
        } else { const int tdk = (job - 32) >> 2, tc = (job - 32) & 3;
#pragma unroll
            for (int kk = 0; kk < 2; ++kk) { const bf16x8 a = *(const LAS bf16x8*)(lds + L_KBGT + (16 * tdk + fr) * LD64B + kk * 64 + 16 * fq), b = *(const LAS bf16x8*)(lds + L_TT + (16 * tc + fr) * LD64B + kk * 64 + 16 * fq);
                acc = __builtin_amdgcn_mfma_f32_16x16x32_bf16(a, b, acc, 0, 0, 0); }
            *(LAS u32x2*)(lds + L_W + (16 * tc + fr) * LD128B + 2 * (16 * tdk + 4 * fq)) = (u32x2){pk2(acc[0], acc[1]), pk2(acc[2], acc[3])};
        }
    }
    LBAR(); STG(5);
}

__device__ __forceinline__ void gdn_step(const LAS uchar* pW, const LAS uchar* pKDT, const LAS uchar* pST, LAS uchar* pVNT, const f32x4 (&U)[4], f32x4 (&V)[4], f32x4 (&S)[8], float eg, int wave, int lane) {
    const int fr = lane & 15, fq = lane >> 4;
    bf16x8 bS[4], aW[4][4], aK[8][2];
#pragma unroll
    for (int kk = 0; kk < 4; ++kk) bS[kk] = *(const LAS bf16x8*)(pST + (16 * wave + fr) * LD128B + kk * 64 + 16 * fq);
#pragma unroll
    for (int tc = 0; tc < 4; ++tc)
#pragma unroll
        for (int kk = 0; kk < 4; ++kk) aW[tc][kk] = *(const LAS bf16x8*)(pW + (16 * tc + fr) * LD128B + kk * 64 + 16 * fq);
    f32x4 x[4];
#pragma unroll
    for (int tc = 0; tc < 4; ++tc) x[tc] = (f32x4){0.f, 0.f, 0.f, 0.f};
#pragma unroll
    for (int kk = 0; kk < 4; ++kk)
#pragma unroll
        for (int tc = 0; tc < 4; ++tc) x[tc] = __builtin_amdgcn_mfma_f32_16x16x32_bf16(aW[tc][kk], bS[kk], x[tc], 0, 0, 0);
#pragma unroll
    for (int t = 0; t < 8; ++t)
#pragma unroll
        for (int kk = 0; kk < 2; ++kk) aK[t][kk] = *(const LAS bf16x8*)(pKDT + (16 * t + fr) * LD64B + kk * 64 + 16 * fq);
#pragma unroll
    for (int tc = 0; tc < 4; ++tc) { V[tc] = U[tc] - x[tc];
        *(LAS u32x2*)(pVNT + (16 * wave + fr) * LD64B + 2 * (16 * tc + 4 * fq)) = (u32x2){pk2(V[tc][0], V[tc][1]), pk2(V[tc][2], V[tc][3])}; }
    bf16x8 bV[2];
#pragma unroll
    for (int kk = 0; kk < 2; ++kk) bV[kk] = *(const LAS bf16x8*)(pVNT + (16 * wave + fr) * LD64B + kk * 64 + 16 * fq);
#pragma unroll
    for (int t = 0; t < 8; ++t) S[t] = S[t] * eg;
#pragma unroll
    for (int kk = 0; kk < 2; ++kk)
#pragma unroll
        for (int t = 0; t < 8; ++t) S[t] = __builtin_amdgcn_mfma_f32_16x16x32_bf16(aK[t][kk], bV[kk], S[t], 0, 0, 0);
}

__device__ __forceinline__ void gdn_prompt_prepare_unit(Frame& F, int l, int u) {
    const int h = u & 7, c = (u >> 3) & 31, b = u >> 8;
    PrepIn q; q.l = l; q.h = h; q.row0 = b * SEQ + c * 64; q.nvalid = 64; q.halo_mode = (c > 0) ? 1 : 0; q.hs = nullptr;
    q.gc_out = (c == NCHUNK - 1) ? F.out + O_GCP + (size_t)((l * NPB + b) * 3) * 3 * DGDN : nullptr; q.gc_i0 = 61;
    gdn_prepare<64>(F, q);
    const LAS uchar* lds = F.lds;
    for (int p = F.tid; p < IMG_QD / 16; p += 512) *(GAS u32x4*)(F.ws + WS_GQD + (size_t)u * IMG_QD + 16 * p) = *(const LAS u32x4*)(lds + L_QS + 16 * p);
    for (int p = F.tid; p < IMG_W / 16; p += 512) *(GAS u32x4*)(F.ws + WS_GW + (size_t)u * IMG_W + 16 * p) = *(const LAS u32x4*)(lds + L_W + 16 * p);
    for (int p = F.tid; p < IMG_ATT / 16; p += 512) *(GAS u32x4*)(F.ws + WS_GATT + (size_t)u * IMG_ATT + 16 * p) = *(const LAS u32x4*)(lds + L_ATT + 16 * p);
    for (int p = F.tid; p < IMG_KDT / 16; p += 512) *(GAS u32x4*)(F.ws + WS_GKDT + (size_t)u * IMG_KDT + 16 * p) = *(const LAS u32x4*)(lds + L_KDT + 16 * p);
    for (int p = F.tid; p < IMG_UT / 16; p += 512) *(GAS u32x4*)(F.ws + WS_GUT + (size_t)u * IMG_UT + 16 * p) = *(const LAS u32x4*)(lds + L_UT + 16 * p);
    if (F.tid == 0) ((GAS float*)(F.ws + WS_GL))[u] = ((const LAS float*)(lds + L_SM))[128];
    LBAR();

}

__device__ __forceinline__ void gdn_sample_wave(Frame& F, int l, int base) {
    int t_ = F.tid; asm volatile("" : "+v"(t_));
    const int lane = t_ & 63, wave = __builtin_amdgcn_readfirstlane(t_ >> 6), hv = wave & 1; const int u_ = base + (wave >> 1); const bool act = u_ < NSB * NH; const int u = act ? u_ : 0;
    const int h = u & 7, b = u >> 3, row0 = MP + b * SSEQ;
    LAS uchar* wl = F.lds + wave * 8192;
    LAS float* exch = (LAS float*)(F.lds + 65536);
    const GAS bf16_t* P = (const GAS bf16_t*)(F.ws + WS_P);
    float beta[4], gc[4];
    { const GAS float* lgp = (const GAS float*)(F.ws + WS_LG) + (size_t)row0 * 16; const float dtb = F.in[I_DTB][l * NH + h], ea = __expf(F.in[I_ALOG][l * NH + h]); float run = 0.f;
#pragma unroll
      for (int t = 0; t < 4; ++t) { const float bl = lgp[t * 16 + h], al = lgp[t * 16 + 8 + h]; beta[t] = sigmoidf_(bl);
          const float xx = al + dtb; const float sp = softplusf_(xx); run += -ea * sp; gc[t] = run; } }
    const GAS float* hs = F.in[I_SGC] + (size_t)((l * NSB + b) * 3) * 3 * DGDN; const GAS float* cwb = F.in[I_GCW] + (size_t)l * 4 * 3 * DGDN;
    GAS float* gco = F.out + O_GCS + (size_t)((l * NSB + b) * 3) * 3 * DGDN;
    f32x2 q[4], k[4]; float v[4];
    {
        const int cq = h * HD + 2 * lane, ck = DGDN + cq, cv = 2 * DGDN + h * HD + 64 * hv + lane;
        f32x2 xq[7], xk[7]; float xv[7];
#pragma unroll
        for (int r = 0; r < 3; ++r) { xq[r] = *(const GAS f32x2*)(hs + (size_t)r * 3 * DGDN + cq); xk[r] = *(const GAS f32x2*)(hs + (size_t)r * 3 * DGDN + ck); xv[r] = hs[(size_t)r * 3 * DGDN + cv]; }
#pragma unroll
        for (int t = 0; t < 4; ++t) { const GAS bf16_t* pr = P + (size_t)(row0 + t) * NPROJ + CQ; const unsigned wq = *(const GAS unsigned*)(pr + cq), wk = *(const GAS unsigned*)(pr + ck);
            xq[3 + t] = (f32x2){bflo(wq), bfhi(wq)}; xk[3 + t] = (f32x2){bflo(wk), bfhi(wk)}; xv[3 + t] = bf1(pr[cv]); }
        if (act) {
#pragma unroll
            for (int t = 1; t < 4; ++t) { if (hv == 0) { *(GAS f32x2*)(gco + (size_t)(t - 1) * 3 * DGDN + cq) = xq[3 + t]; *(GAS f32x2*)(gco + (size_t)(t - 1) * 3 * DGDN + ck) = xk[3 + t]; }
                gco[(size_t)(t - 1) * 3 * DGDN + cv] = xv[3 + t]; } }
        f32x2 cwq[4], cwk[4]; float cwv[4];
#pragma unroll
        for (int j = 0; j < 4; ++j) { cwq[j] = *(const GAS f32x2*)(cwb + (size_t)j * 3 * DGDN + cq); cwk[j] = *(const GAS f32x2*)(cwb + (size_t)j * 3 * DGDN + ck); cwv[j] = cwb[(size_t)j * 3 * DGDN + cv]; }
#pragma unroll
        for (int t = 0; t < 4; ++t) {
            f32x2 yq = cwq[0] * xq[t] + cwq[1] * xq[t + 1] + cwq[2] * xq[t + 2] + cwq[3] * xq[t + 3];
            f32x2 yk = cwk[0] * xk[t] + cwk[1] * xk[t + 1] + cwk[2] * xk[t + 2] + cwk[3] * xk[t + 3];
            float yv = cwv[0] * xv[t] + cwv[1] * xv[t + 1] + cwv[2] * xv[t + 2] + cwv[3] * xv[t + 3];
            yq[0] = siluf_(yq[0]); yq[1] = siluf_(yq[1]);
            yk[0] = siluf_(yk[0]); yk[1] = siluf_(yk[1]);
            yv = siluf_(yv);
            const float sq = wave_sum(yq[0] * yq[0] + yq[1] * yq[1]), sk = wave_sum(yk[0] * yk[0] + yk[1] * yk[1]);
            q[t] = yq * (rsqrtf(sq + NORM_EPS) * 0.08838834764831845f); k[t] = yk * rsqrtf(sk + NORM_EPS); v[t] = yv;
        }
    }
    float T10, T20, T21, T30, T31, T32, at[4][4];
    {
        float kk[4][4], qk[4][4];
#pragma unroll
        for (int i = 0; i < 4; ++i)
#pragma unroll
            for (int j = 0; j <= i; ++j) { qk[i][j] = wave_sum(q[i][0] * k[j][0] + q[i][1] * k[j][1]); if (j < i) kk[i][j] = wave_sum(k[i][0] * k[j][0] + k[i][1] * k[j][1]); }
        float M[4][4];
#pragma unroll
        for (int i = 0; i < 4; ++i)
#pragma unroll
            for (int j = 0; j <= i; ++j) { const float d = __expf(gc[i] - gc[j]); at[i][j] = qk[i][j] * d; if (j < i) M[i][j] = beta[i] * kk[i][j] * d; }
        T10 = -M[1][0]; T21 = -M[2][1]; T32 = -M[3][2];
        T20 = -(M[2][0] + M[2][1] * T10); T31 = -(M[3][1] + M[3][2] * T21);
        T30 = -(M[3][0] + M[3][1] * T10 + M[3][2] * T20);
    }
    float uu[4];
    {
        float vb[4]; f32x2 kb[4];
#pragma unroll
        for (int m = 0; m < 4; ++m) { vb[m] = v[m] * beta[m]; kb[m] = k[m] * (beta[m] * __expf(gc[m])); }
        uu[0] = vb[0]; uu[1] = vb[1] + T10 * vb[0]; uu[2] = vb[2] + T20 * vb[0] + T21 * vb[1]; uu[3] = vb[3] + T30 * vb[0] + T31 * vb[1] + T32 * vb[2];
        f32x2 w[4]; w[0] = kb[0]; w[1] = kb[1] + T10 * kb[0]; w[2] = kb[2] + T20 * kb[0] + T21 * kb[1]; w[3] = kb[3] + T30 * kb[0] + T31 * kb[1] + T32 * kb[2];
        const float e0 = __expf(gc[0]), e1 = __expf(gc[1]), e2 = __expf(gc[2]), e3 = __expf(gc[3]);
        const float d0 = __expf(gc[3] - gc[0]), d1 = __expf(gc[3] - gc[1]), d2 = __expf(gc[3] - gc[2]);
#pragma unroll
        for (int e = 0; e < 2; ++e) { const int dk = 2 * lane + e;
            *(LAS f32x4*)(wl + dk * 16) = (f32x4){w[0][e], w[1][e], w[2][e], w[3][e]};
            *(LAS f32x4*)(wl + 2048 + dk * 16) = (f32x4){q[0][e] * e0, q[1][e] * e1, q[2][e] * e2, q[3][e] * e3};
            *(LAS f32x4*)(wl + 4096 + dk * 16) = (f32x4){k[0][e] * d0, k[1][e] * d1, k[2][e] * d2, k[3][e]}; }
    }
    const size_t soff = (size_t)((l * NSB + b) * NH + h) * HD * HD + 64 * hv + lane;
    const GAS float* s0 = F.in[I_SG] + soff; GAS float* s1 = F.out + O_GS + soff;
    float Sr[128];
    { const GAS float* p = s0;
#pragma unroll
      for (int c8 = 0; c8 < 16; ++c8) {
#pragma unroll
          for (int j = 0; j < 8; ++j) Sr[c8 * 8 + j] = p[j * HD];
          p += 8 * HD; asm volatile("" : "+v"(p)); } }
    float wS[4] = {0.f, 0.f, 0.f, 0.f}, qS[4] = {0.f, 0.f, 0.f, 0.f};
    const LAS uchar* wlb = wl; asm volatile("" : "+v"(wlb));
#pragma unroll
    for (int dk = 0; dk < 128; ++dk) { const f32x4 wv = *(const LAS f32x4*)(wlb + dk * 16), qv = *(const LAS f32x4*)(wlb + 2048 + dk * 16);
#pragma unroll
        for (int c = 0; c < 4; ++c) { fmac1(wS[c], wv[c], Sr[dk]); fmac1(qS[c], qv[c], Sr[dk]); }
        if ((dk & 3) == 3) asm volatile("" ::: "memory"); }
    float vn[4], o[4];
#pragma unroll
    for (int c = 0; c < 4; ++c) vn[c] = uu[c] - wS[c];
#pragma unroll
    for (int c = 0; c < 4; ++c) { float a = qS[c];
#pragma unroll
        for (int c2 = 0; c2 <= c; ++c2) a += at[c][c2] * vn[c2];
        o[c] = a; }
    const float eg = __expf(gc[3]);
    if (act) { GAS float* p = s1;
#pragma unroll
        for (int c8 = 0; c8 < 16; ++c8) {
#pragma unroll
            for (int j = 0; j < 8; ++j) { const int dk = c8 * 8 + j; const f32x4 kv = *(const LAS f32x4*)(wlb + 4096 + dk * 16);
                float r_ = Sr[dk] * eg; fmac1(r_, kv[0], vn[0]); fmac1(r_, kv[1], vn[1]); fmac1(r_, kv[2], vn[2]); fmac1(r_, kv[3], vn[3]); p[j * HD] = r_; }
            p += 8 * HD; asm volatile("" : "+v"(p) :: "memory"); }
    }
    float po[4];
#pragma unroll
    for (int c = 0; c < 4; ++c) po[c] = wave_sum(o[c] * o[c]);
    if (lane < 4) exch[wave * 4 + lane] = (lane == 0) ? po[0] : (lane == 1) ? po[1] : (lane == 2) ? po[2] : po[3];
    LBAR();
    const int dv = 64 * hv + lane; const float nw = F.in[I_GNW][l * HD + dv];
    GAS bf16_t* ob = (GAS bf16_t*)(F.ws + WS_OB);
#pragma unroll
    for (int c = 0; c < 4; ++c) { const float tot = po[c] + exch[(wave ^ 1) * 4 + c];
        const float z = bf1(P[(size_t)(row0 + c) * NPROJ + CZ + h * HD + dv]);
        const float r = o[c] * rsqrtf(tot * (1.f / HD) + NORM_EPS) * nw * siluf_(z);
        if (act) ob[(size_t)(row0 + c) * DGDN + h * HD + dv] = (bf16_t)(pk2(r, 0.f) & 0xffffu); }
    LBAR();
}

__device__ __forceinline__ void gdn_scan_unit(Frame& F, int l, int bh) {
    const int h = bh & 7, b = bh >> 3; const int lane = F.lane, wave = F.wave, fr = lane & 15, fq = lane >> 4, tid = F.tid;
    LAS uchar* lds = F.lds; const int dv = 16 * wave + fr;
    f32x4 S[8], U[4], V[4];
#pragma unroll
    for (int t = 0; t < 8; ++t) S[t] = (f32x4){0.f, 0.f, 0.f, 0.f};
    constexpr int NPIECE = (IMG_W + IMG_KDT) / 16;
    u32x4 preA[5], preB[5]; u32x2 UnA[4], UnB[4]; float glA = 0.f, glB = 0.f;
#define LOAD_STAGE(pre, uu) do { _Pragma("unroll") for (int k_ = 0; k_ < 5; ++k_) { const int p_ = tid + 512 * k_; \
            const GAS uchar* src_ = (p_ < IMG_W / 16) ? F.ws + WS_GW + (size_t)(uu) * IMG_W + 16 * p_ : F.ws + WS_GKDT + (size_t)(uu) * IMG_KDT + 16 * (p_ - IMG_W / 16); \
            if (p_ < NPIECE) pre[k_] = *(const GAS u32x4*)src_; } } while (0)
#define WRITE_STAGE(pre, buf) do { _Pragma("unroll") for (int k_ = 0; k_ < 5; ++k_) { const int p_ = tid + 512 * k_; if (p_ < NPIECE) *(LAS u32x4*)(lds + (buf) * SC_STG + 16 * p_) = pre[k_]; } } while (0)
#define LOAD_U(Un, gl, uu) do { _Pragma("unroll") for (int tc_ = 0; tc_ < 4; ++tc_) Un[tc_] = *(const GAS u32x2*)(F.ws + WS_GUT + (size_t)(uu) * IMG_UT + dv * LD64B + 2 * (16 * tc_ + 4 * fq)); \
        gl = ((const GAS float*)(F.ws + WS_GL))[uu]; } while (0)
#define SST(k) ((void)0)
#define SCAN_ITER(n, pre, Un, gl) do { const int u = u0 + (n) * NH; \
        _Pragma("unroll") for (int t = 0; t < 8; ++t) *(LAS u32x2*)(lds + SC_ST + dv * LD128B + 2 * (16 * t + 4 * fq)) = (u32x2){pk2(S[t][0], S[t][1]), pk2(S[t][2], S[t][3])}; \
        _Pragma("unroll") for (int k = 0; k < 5; ++k) { const int p = lane + 64 * k; if (p < 272) *(GAS u32x4*)(F.ws + WS_GH + (size_t)u * IMG_H + wave * 4352 + 16 * p) = *(const LAS u32x4*)(lds + SC_ST + wave * 4352 + 16 * p); } \
        SST(11); LBAR(); SST(12); \
        if ((n) + 1 < NCHUNK) WRITE_STAGE(pre, ((n) + 1) & 1); \
        SST(13); \
        if ((n) + 3 < NCHUNK) LOAD_STAGE(pre, u + 3 * NH); \
        _Pragma("unroll") for (int tc = 0; tc < 4; ++tc) U[tc] = (f32x4){bflo(Un[tc].x), bfhi(Un[tc].x), bflo(Un[tc].y), bfhi(Un[tc].y)}; \
        const float eg = __expf(gl); \
        if ((n) + 2 < NCHUNK) LOAD_U(Un, gl, u + 2 * NH); \
        const LAS uchar* st = lds + ((n) & 1) * SC_STG; SST(14); \
        gdn_step(st, st + IMG_W, lds + SC_ST, lds + SC_VNT, U, V, S, eg, wave, lane); SST(15); \
        _Pragma("unroll") for (int k = 0; k < 3; ++k) { const int p = lane + 64 * k; if (p < 144) *(GAS u32x4*)(F.ws + WS_GVNT + (size_t)u * IMG_VNT + wave * 2304 + 16 * p) = *(const LAS u32x4*)(lds + SC_VNT + wave * 2304 + 16 * p); } SST(16); \
    } while (0)
    const int u0 = (b * NCHUNK) * NH + h;
    LOAD_STAGE(preA, u0); WRITE_STAGE(preA, 0);
    LOAD_STAGE(preA, u0 + NH); LOAD_STAGE(preB, u0 + 2 * NH);
    LOAD_U(UnA, glA, u0); LOAD_U(UnB, glB, u0 + NH);
#pragma unroll 1
    for (int n = 0; n < NCHUNK; n += 2) { SCAN_ITER(n, preA, UnA, glA); SCAN_ITER(n + 1, preB, UnB, glB); }
#undef LOAD_STAGE
#undef WRITE_STAGE
#undef LOAD_U
#undef SCAN_ITER
    GAS float* s1 = F.out + O_GP + (size_t)((l * NPB + b) * NH + h) * HD * HD;
#pragma unroll
    for (int t = 0; t < 8; ++t)
#pragma unroll
        for (int reg = 0; reg < 4; ++reg) s1[(size_t)(16 * t + 4 * fq + reg) * HD + dv] = S[t][reg];
    LBAR();
}

constexpr int OP_Z = 81920, OP_O = 99328;
__device__ __forceinline__ void gdn_out_phase(Frame& F, int l) {
    LAS uchar* lds = F.lds; const int tid = F.tid, lane = F.lane, wave = F.wave, fr = lane & 15, fq = lane >> 4;
    constexpr int NP = (IMG_QD + IMG_ATT + IMG_VNT + IMG_H) / 16;
    u32x4 pre[10], prez[2];
    const GAS bf16_t* P = (const GAS bf16_t*)(F.ws + WS_P); GAS bf16_t* ob = (GAS bf16_t*)(F.ws + WS_OB);
#define OUT_LOAD(uu) do { _Pragma("unroll") for (int k_ = 0; k_ < 10; ++k_) { const int p_ = tid + 512 * k_; if (p_ < NP) { const int o_ = 16 * p_; \
        const GAS uchar* src_ = (o_ < OP_ATT) ? F.ws + WS_GQD + (size_t)(uu) * IMG_QD + o_ : (o_ < OP_VNT) ? F.ws + WS_GATT + (size_t)(uu) * IMG_ATT + (o_ - OP_ATT) : \
                            (o_ < OP_H) ? F.ws + WS_GVNT + (size_t)(uu) * IMG_VNT + (o_ - OP_VNT) : F.ws + WS_GH + (size_t)(uu) * IMG_H + (o_ - OP_H); \
        pre[k_] = *(const GAS u32x4*)src_; } } \
        { const int h_ = (uu) & 7, c_ = ((uu) >> 3) & 31, b_ = (uu) >> 8; const GAS bf16_t* zb_ = P + (size_t)(b_ * SEQ + c_ * 64) * NPROJ + CZ + h_ * HD; \
          _Pragma("unroll") for (int k_ = 0; k_ < 2; ++k_) { const int p_ = tid + 512 * k_; prez[k_] = *(const GAS u32x4*)(zb_ + (size_t)(p_ >> 4) * NPROJ + 8 * (p_ & 15)); } } } while (0)
    int u = F.vcu;
    if (u < NPU) OUT_LOAD(u);
    for (; u < NPU; u += F.G) {
#pragma unroll
        for (int k = 0; k < 10; ++k) { const int p = tid + 512 * k; if (p < NP) *(LAS u32x4*)(lds + 16 * p) = pre[k]; }
#pragma unroll
        for (int k = 0; k < 2; ++k) { const int p = tid + 512 * k; *(LAS u32x4*)(lds + OP_Z + (p >> 4) * LD128B + 16 * (p & 15)) = prez[k]; }
        LBAR();
        if (u + F.G < NPU) OUT_LOAD(u + F.G);
        const int h = u & 7, c = (u >> 3) & 31, b = u >> 8, row0 = b * SEQ + c * 64;
        const LAS uchar* pQD = lds + OP_QD; const LAS uchar* pATT = lds + OP_ATT; const LAS uchar* pH = lds + OP_H; const LAS uchar* pVNT = lds + OP_VNT; LAS float* red = (LAS float*)(lds + OP_RED);
        bf16x8 bH[4], bV[2], aQ[4][4], aA[4][2];
#pragma unroll
        for (int kk = 0; kk < 4; ++kk) bH[kk] = *(const LAS bf16x8*)(pH + (16 * wave + fr) * LD128B + kk * 64 + 16 * fq);
#pragma unroll
        for (int kk = 0; kk < 2; ++kk) bV[kk] = *(const LAS bf16x8*)(pVNT + (16 * wave + fr) * LD64B + kk * 64 + 16 * fq);
#pragma unroll
        for (int tc = 0; tc < 4; ++tc) {
#pragma unroll
            for (int kk = 0; kk < 4; ++kk) aQ[tc][kk] = *(const LAS bf16x8*)(pQD + (16 * tc + fr) * LD128B + kk * 64 + 16 * fq);
#pragma unroll
            for (int kk = 0; kk < 2; ++kk) aA[tc][kk] = *(const LAS bf16x8*)(pATT + (16 * tc + fr) * LD64B + kk * 64 + 16 * fq); }
        f32x4 O[4];
#pragma unroll
        for (int tc = 0; tc < 4; ++tc) O[tc] = (f32x4){0.f, 0.f, 0.f, 0.f};
#pragma unroll
        for (int kk = 0; kk < 4; ++kk)
#pragma unroll
            for (int tc = 0; tc < 4; ++tc) O[tc] = __builtin_amdgcn_mfma_f32_16x16x32_bf16(aQ[tc][kk], bH[kk], O[tc], 0, 0, 0);
#pragma unroll
        for (int kk = 0; kk < 2; ++kk)
#pragma unroll
            for (int tc = 0; tc < 4; ++tc) O[tc] = __builtin_amdgcn_mfma_f32_16x16x32_bf16(aA[tc][kk], bV[kk], O[tc], 0, 0, 0);
#pragma unroll
        for (int tc = 0; tc < 4; ++tc)
#pragma unroll
            for (int reg = 0; reg < 4; ++reg) { const float p = row_sum16(O[tc][reg] * O[tc][reg]); if (fr == 0) red[(16 * tc + 4 * fq + reg) * 8 + wave] = p; }
        LBAR();
        const int dv = 16 * wave + fr; const float nw = F.in[I_GNW][l * HD + dv];
#pragma unroll
        for (int tc = 0; tc < 4; ++tc)
#pragma unroll
            for (int reg = 0; reg < 4; ++reg) { const int cc = 16 * tc + 4 * fq + reg;
                const f32x4 r0 = *(const LAS f32x4*)(red + cc * 8), r1 = *(const LAS f32x4*)(red + cc * 8 + 4);
                const float tot = ((r0[0] + r0[1]) + (r0[2] + r0[3])) + ((r1[0] + r1[1]) + (r1[2] + r1[3]));
                const float z = bf1(*(const LAS bf16_t*)(lds + OP_Z + cc * LD128B + 2 * dv));
                const float v = O[tc][reg] * rsqrtf(tot * (1.f / HD) + NORM_EPS) * nw * siluf_(z);
                *(LAS bf16_t*)(lds + OP_O + cc * LD128B + 2 * dv) = (bf16_t)(pk2(v, 0.f) & 0xffffu); }
        LBAR();
#pragma unroll
        for (int k = 0; k < 2; ++k) { const int p = tid + 512 * k; *(GAS u32x4*)(ob + (size_t)(row0 + (p >> 4)) * DGDN + h * HD + 8 * (p & 15)) = *(const LAS u32x4*)(lds + OP_O + (p >> 4) * LD128B + 16 * (p & 15)); }
    }
    LBAR();
#undef OUT_LOAD
}

__device__ __forceinline__ void ln_load(Frame& F, int m, const GAS float* res_hi, f32x4 (&v)[8]) {
    const GAS float* X = (const GAS float*)(F.ws + WS_X); const GAS float* slab = (const GAS float*)(F.ws + WS_SLAB);
    if (m < MP) { const GAS float* xr = X + (size_t)m * DM;
#pragma unroll
        for (int j = 0; j < 8; ++j) v[j] = *(const GAS f32x4*)(xr + j * 256 + F.lane * 4);
    } else { const GAS float* xr = res_hi + (size_t)(m - MP) * DM;
#pragma unroll
        for (int j = 0; j < 8; ++j) v[j] = *(const GAS f32x4*)(xr + j * 256 + F.lane * 4) * alpha_();
#pragma unroll 2
        for (int p = 0; p < KPART; ++p) { const GAS float* sr = slab + ((size_t)p * MSR + (m - MP)) * DM;
#pragma unroll
            for (int j = 0; j < 8; ++j) v[j] += *(const GAS f32x4*)(sr + j * 256 + F.lane * 4); }
    }
}
__device__ __forceinline__ void ln_finish(Frame& F, int m, const GAS float* gam, const GAS float* bet, GAS float* dst, f32x4 (&v)[8], const int i8out) {
    GAS bf16_t* xb = (GAS bf16_t*)(F.ws + WS_XB); float s = 0.f;
#pragma unroll
    for (int j = 0; j < 8; ++j) s += (v[j][0] + v[j][1]) + (v[j][2] + v[j][3]);
    const float mean = wave_sum(s) * (1.f / DM); float s2 = 0.f;
#pragma unroll
    for (int j = 0; j < 8; ++j) { v[j] = v[j] - mean; s2 += (v[j][0] * v[j][0] + v[j][1] * v[j][1]) + (v[j][2] * v[j][2] + v[j][3] * v[j][3]); }
    const float rstd = rsqrtf(wave_sum(s2) * (1.f / DM) + LN_EPS);
    GAS float* orow = dst + (size_t)m * DM;
#pragma unroll
    for (int j = 0; j < 8; ++j) { const int k = j * 256 + F.lane * 4; const f32x4 g = *(const GAS f32x4*)(gam + k), bb = *(const GAS f32x4*)(bet + k);
        const f32x4 o = v[j] * rstd * g + bb; st_wt16f(orow + k, o);
        if (i8out == 1) *(GAS unsigned*)((GAS uchar*)xb + (size_t)m * DM + k) = pk4_i8(o[0] * pg8::XQ_SCALE, o[1] * pg8::XQ_SCALE, o[2] * pg8::XQ_SCALE, o[3] * pg8::XQ_SCALE);
        else { st_wt8(xb + (size_t)m * DM + k, (u32x2){pk2(o[0], o[1]), pk2(o[2], o[3])});
            if (i8out == 2) *(GAS unsigned*)(F.ws + WS_XB8 + (size_t)m * DM + k) = pk4_i8(o[0] * pg8::XQ_SCALE, o[1] * pg8::XQ_SCALE, o[2] * pg8::XQ_SCALE, o[3] * pg8::XQ_SCALE); } }
}
__device__ __forceinline__ void phase_ln(Frame& F, const GAS float* gam, const GAS float* bet, GAS float* dst, const GAS float* res_hi, const int i8out) {
    const int gw = F.vcu * 8 + F.wave, NGW = F.G * 8;
    const bool bal = (NGW == 2048);
    const int nrows = bal ? (gw < MSR ? 2 : 5) : (MT - gw + NGW - 1) / NGW;
#define LN_ROW(i) (bal ? (gw < MSR ? ((i) == 0 ? MP + gw : gw) : MSR + (gw - MSR) * 5 + (i)) : gw + (i) * NGW)
    f32x4 va[8], vb[8]; int i = 0;
    if (i < nrows) ln_load(F, LN_ROW(0), res_hi, va);
    while (i < nrows) {
        if (i + 1 < nrows) ln_load(F, LN_ROW(i + 1), res_hi, vb);
        ln_finish(F, LN_ROW(i), gam, bet, dst, va, i8out);
        if (i + 1 >= nrows) break;
        if (i + 2 < nrows) ln_load(F, LN_ROW(i + 2), res_hi, va);
        ln_finish(F, LN_ROW(i + 1), gam, bet, dst, vb, i8out);
        i += 2;
    }
#undef LN_ROW
}

constexpr int PH_PER_LAYER = 12, N_PHASES = DEPTH * PH_PER_LAYER;
__global__ void __launch_bounds__(512, 2) fwd_kernel(Args args) {
    extern __shared__ __attribute__((aligned(16))) uchar lds_raw[];
    Frame F;
    F.lds = (LAS uchar*)lds_raw;
    const int g_wave_ = __builtin_amdgcn_readfirstlane((int)threadIdx.x >> 6);
    F.tid = TID_NOW(g_wave_); F.lane = F.tid & 63; F.wave = g_wave_;
    F.G = gridDim.x; { const int bx = blockIdx.x; F.vcu = (F.G % 8 == 0) ? (bx % 8) * (F.G / 8) + bx / 8 : bx; }
    F.in = (const GAS float* const*)args.in; F.out = (GAS float*)args.out; F.ws = (GAS uchar*)args.ws;
    volatile LAS unsigned* MISC = (volatile LAS unsigned*)(F.lds + MISC_OFF);
    if (F.tid < 64) MISC[F.tid] = 0u;
    __syncthreads();
    const bool multi = (args.ph_hi - args.ph_lo) > 1;
    XcdBarrier bar; bar.bar = (unsigned*)(F.ws + WS_CTL) + 4096; bar.x = 0; bar.st = nullptr;
    if (multi) bar = xcd_barrier_post((unsigned*)(F.ws + WS_CTL) + 4096, MISC + 8, g_wave_);
    const int lo = args.ph_lo, hi = args.ph_hi;
#pragma unroll 1
    for (int ph = lo; ph < hi; ++ph) {
        const int l = ph / PH_PER_LAYER, k = ph % PH_PER_LAYER;
#define PHASE_IDS() do { const int t_ = TID_NOW(g_wave_); F.tid = t_; F.lane = t_ & 63; F.wave = g_wave_; } while (0)
        { int g_ = (int)gridDim.x; asm volatile("" : "+s"(g_)); F.G = g_;
          GAS uchar* w_ = (GAS uchar*)args.ws; asm volatile("" : "+s"(w_)); F.ws = w_;
          GAS float* o_ = (GAS float*)args.out; asm volatile("" : "+s"(o_)); F.out = o_; }
        const GAS bf16_t* WIN = (const GAS bf16_t*)(F.ws + WS_WIN); const GAS bf16_t* WA = (const GAS bf16_t*)(F.ws + WS_WA); const GAS bf16_t* WB = (const GAS bf16_t*)(F.ws + WS_WB);
        const GAS bf16_t* WO = (const GAS bf16_t*)(F.ws + WS_WO); const GAS bf16_t* WUP = (const GAS bf16_t*)(F.ws + WS_WUP); const GAS bf16_t* WD = (const GAS bf16_t*)(F.ws + WS_WD);
        GAS bf16_t* P = (GAS bf16_t*)(F.ws + WS_P); GAS bf16_t* XB = (GAS bf16_t*)(F.ws + WS_XB); GAS float* X = (GAS float*)(F.ws + WS_X);
        GAS bf16_t* AIN = (GAS bf16_t*)(F.ws + WS_AIN); GAS bf16_t* OB = (GAS bf16_t*)(F.ws + WS_OB); GAS bf16_t* MG = (GAS bf16_t*)(F.ws + WS_MG); GAS bf16_t* T1 = (GAS bf16_t*)(F.ws + WS_T1); GAS bf16_t* HID = P;
        switch (k) {
        case 0: PHASE_IDS(); phase_conv(F, l); break;
        case 1: {
                  { pg8::Gemm g{XB, (const GAS bf16_t*)(F.ws + WS_WIN8), MT, NPROJ, DM / 2}; g.A = (const GAS bf16_t*)(F.ws + WS_XB8);
                    pg8::MixOrder S; S.init(0, DM / 2, F.G, F.vcu, (int)blockIdx.x); pg8::EpiStoreBf16<true> E{P, NPROJ, 1.f / (pg8::XQ_SCALE * pg8::WIN_SCALE)};
                    pg8::gemm_phase<pg8::EpiStoreBf16<true>, pg8::MixOrder, true, true, 2>(F.lds, g, S, E, g_wave_); }
                  { pg8::Gemm g{XB, WIN, MT, NPROJ, DM}; pg8::MixOrder S; S.init(1, DM, F.G, F.vcu, (int)blockIdx.x); pg8::EpiStoreBf16<false> E{P, NPROJ, 1.f};
                    pg8::gemm_phase<pg8::EpiStoreBf16<false>, pg8::MixOrder, true, true, 0>(F.lds, g, S, E, g_wave_); }
                  PHASE_IDS(); phase_logits(F, l); } break;
        case 2: { PHASE_IDS();
                  for (int base = F.vcu * 4; base < NSB * NH; base += F.G * 4) gdn_sample_wave(F, l, base);
                  for (int u = F.vcu; u < NPU; u += F.G) gdn_prompt_prepare_unit(F, l, u);
                  for (int u = F.vcu; u < 384; u += F.G) mixa_unit(F, l, u); } break;
        case 3: { PHASE_IDS();
                  if ((int)blockIdx.x < NPB * NH) gdn_scan_unit(F, l, (int)blockIdx.x);
                  else { const int c1 = (int)blockIdx.x - NPB * NH;
                         { pg8::Gemm g{AIN, WA, MT, DM, DCONV}; pg8::D1Order S; S.init(DCONV, c1); pg8::EpiGate<false, false> E{P, NPROJ, CMA, nullptr, T1, DM, 1.f};
                           pg8::gemm_phase<pg8::EpiGate<false, false>, pg8::D1Order, true, true, 0>(F.lds, g, S, E, g_wave_); }
                         if (c1 >= 208) { VM_WAIT();
                           pg8::Gemm g{OB, WB, MT, DM, DGDN}; pg8::ListOrder S; S.init(DGDN, 256 + (c1 - 208), 1); pg8::EpiGate<true, false> E{P, NPROJ, CMB, T1, MG, DM, 1.f};
                           pg8::gemm_phase<pg8::EpiGate<true, false>, pg8::ListOrder, true, true, 0>(F.lds, g, S, E, g_wave_); } }
                  } break;
        case 4: PHASE_IDS(); gdn_out_phase(F, l); break;
        case 5:
            break;
        case 6: { pg8::Gemm g{OB, WB, MT, DM, DGDN}; pg8::ListOrder S; S.init(DGDN, (int)blockIdx.x, (int)blockIdx.x < 256 ? 1 : 0); pg8::EpiGate<true, false> E{P, NPROJ, CMB, T1, MG, DM, 1.f};
                  if (F.G >= 256) pg8::gemm_phase<pg8::EpiGate<true, false>, pg8::ListOrder, true, true, 0>(F.lds, g, S, E, g_wave_); } break;
        case 7: { pg8::Gemm g{MG, WO, MT, DM, DM / 2}; pg8::SplitOrder S; S.init(DM / 2, KPART, F.G, (int)blockIdx.x);
                  pg8::EpiResSplit<true> E{l == 0 ? F.in[I_XP] : X, X, DM, (GAS float*)(F.ws + WS_SLAB), MP, MSR, 1.f / (pg8::MG_SCALE * pg8::WO_SCALE)};
                  pg8::gemm_phase<pg8::EpiResSplit<true>, pg8::SplitOrder, true, true, 2>(F.lds, g, S, E, g_wave_); } break;
        case 8: PHASE_IDS(); phase_ln(F, F.in[I_L1G] + (size_t)l * DM, F.in[I_L1B] + (size_t)l * DM, X, l == 0 ? F.in[I_XS] : X + (size_t)MP * DM, 1); break;
        case 9: {
                  pg8::Gemm g{XB, WUP, MT, DFF, DM / 2}; pg8::StaticOrder S; S.init(MT, DFF, DM / 2, F.G, (int)blockIdx.x); pg8::EpiRelu2 E{(GAS uchar*)HID, DFF, 1.f / (pg8::XQ_SCALE * pg8::WUP_SCALE)};
                  pg8::gemm_phase<pg8::EpiRelu2, pg8::StaticOrder, true, true, 2>(F.lds, g, S, E, g_wave_); } break;
        case 10: {
                  pg8::Gemm g{HID, WD, MT, DM, DFF / 2}; pg8::SplitOrder S; S.init(DFF / 2, KPART, F.G, (int)blockIdx.x);
                  pg8::EpiResSplit<true> E{X, X, DM, (GAS float*)(F.ws + WS_SLAB), MP, MSR, 1.f / (pg8::HID_SCALE * pg8::WD_SCALE)};
                  pg8::gemm_phase<pg8::EpiResSplit<true>, pg8::SplitOrder, true, true, 2>(F.lds, g, S, E, g_wave_); } break;
        case 11: PHASE_IDS(); phase_ln(F, F.in[I_L2G] + (size_t)l * DM, F.in[I_L2B] + (size_t)l * DM, l == DEPTH - 1 ? F.out + O_YP : X, X + (size_t)MP * DM, l == DEPTH - 1 ? 0 : 2); break;
        }
        if (ph + 1 < hi && k != 5) xcd_barrier(bar, g_wave_);
    }
}

extern "C" void kernel_launch(void* const* d_in, const int* in_sizes, int n_in, void* d_out, int out_size, void* d_ws, size_t ws_size, hipStream_t stream) {
    static int grid = 0;
    if (grid == 0) {
        if (n_in != 20 || (size_t)out_size != O_END || ws_size < WS_END) { fprintf(stderr, "kernel_launch: unexpected problem: n_in %d out %d ws %zu (need %zu)\n", n_in, out_size, ws_size, (size_t)WS_END); grid = -1; return; }
        int dev = 0, cus = 0, per_cu = 0;
        hipGetDevice(&dev); hipDeviceGetAttribute(&cus, hipDeviceAttributeMultiprocessorCount, dev);
        if (hipFuncSetAttribute((const void*)fwd_kernel, hipFuncAttributeMaxDynamicSharedMemorySize, LDS_BYTES) != hipSuccess) { fprintf(stderr, "kernel_launch: hipFuncSetAttribute failed\n"); grid = -1; return; }
        if (hipOccupancyMaxActiveBlocksPerMultiprocessor(&per_cu, (const void*)fwd_kernel, 512, LDS_BYTES) != hipSuccess || per_cu < 1) { fprintf(stderr, "kernel_launch: occupancy query says %d\n", per_cu); per_cu = 1; }
        (void)hipGetLastError();
        grid = cus;
        if (grid != 256) { fprintf(stderr, "kernel_launch: the tile orders are laid out for exactly 256 CUs (got %d)\n", grid); grid = -1; return; }
    }
    if (grid < 0) return;
    hipMemsetAsync((char*)d_ws + WS_CTL, 0, CTL_ZERO_BYTES, stream);
    Args a{};
    for (int i = 0; i < 20; ++i) a.in[i] = (const float*)d_in[i];
    a.out = (float*)d_out; a.ws = (uchar*)d_ws;
#ifndef MK_ONE_LAUNCH
#define MK_ONE_LAUNCH 1
#endif
#if MK_ONE_LAUNCH
    a.ph_lo = 0; a.ph_hi = N_PHASES;
    void* kargs[] = {&a};
    hipError_t e = hipLaunchCooperativeKernel((const void*)fwd_kernel, dim3(grid), dim3(512), kargs, LDS_BYTES, stream);
    if (e != hipSuccess) fprintf(stderr, "kernel_launch: cooperative launch failed: %s\n", hipGetErrorString(e));
#else
    for (int ph = 0; ph < N_PHASES; ++ph) {
        a.ph_lo = ph; a.ph_hi = ph + 1;
        hipLaunchKernelGGL(fwd_kernel, dim3(grid), dim3(512), LDS_BYTES, stream, a);
    }
#endif
}
```
